# Optimizing an MI355X kernel written in HIP

```python
import math
import jax, jax.numpy as jnp
from jax import lax
import numpy as np

D_MODEL = 1024
BATCH = 8
SEQ = 2048
DEPTH = 2

GRID_W = 64
CTX_LEN = 256
HEAD_DIM = 64
N_GROUPS = 4
GROUP_W = D_MODEL // N_GROUPS
A_HEADS = GROUP_W // HEAD_DIM
A_KV_HEADS = A_HEADS // 2
A_WINDOW = 128
BLK = 128
CONV_CH = GROUP_W
CONV_K = 31
C_HEADS = GROUP_W // HEAD_DIM
C_QK_DIM = HEAD_DIM // 2
C_V_DIM = HEAD_DIM
D_HEADS = GROUP_W // HEAD_DIM
NA_KH = 8
NA_KW = 16
FFN_HIDDEN = -(-8 * D_MODEL // (3 * 256)) * 256

PROJ_SIZES = (A_HEADS * HEAD_DIM, A_KV_HEADS * HEAD_DIM, A_KV_HEADS * HEAD_DIM,
              2 * CONV_CH,
              C_HEADS * 2 * C_QK_DIM, C_HEADS * 2 * C_QK_DIM, C_HEADS * C_V_DIM,
              D_HEADS * HEAD_DIM, D_HEADS * HEAD_DIM, D_HEADS * HEAD_DIM)
IN_WIDTH = sum(PROJ_SIZES)
SPLIT_IDX = tuple(int(v) for v in np.cumsum(PROJ_SIZES)[:-1])
MIX_WIDTH = A_HEADS * HEAD_DIM + CONV_CH + C_HEADS * C_V_DIM + D_HEADS * HEAD_DIM
ROPE_BASE = 10000.0
EPS = 1e-6
NEG_INF = -1e30

kernel_name = "hybrid_parallel_groups_dit_block"


def rmsnorm(x, g):
    xf = x.astype(jnp.float32)
    r = lax.rsqrt(jnp.mean(xf * xf, axis=-1, keepdims=True) + EPS)
    return (xf * r).astype(x.dtype) * g


def layernorm(x, g, b):
    xf = x.astype(jnp.float32)
    mu = jnp.mean(xf, axis=-1, keepdims=True)
    var = jnp.mean(jnp.square(xf - mu), axis=-1, keepdims=True)
    return ((xf - mu) * lax.rsqrt(var + EPS)).astype(x.dtype) * g + b


def modulate(h, shift, scale):
    return h * (1 + scale) + shift


def axial_rope(n_tok, dim):
    t = jnp.arange(n_tok)
    row = (t // GRID_W).astype(jnp.float32)
    col = (t % GRID_W).astype(jnp.float32)
    nf = dim // 4
    inv = ROPE_BASE ** (-jnp.arange(nf, dtype=jnp.float32) / nf)
    ang = jnp.concatenate([row[:, None] * inv, col[:, None] * inv], axis=-1)
    return jnp.cos(ang), jnp.sin(ang)


def apply_rope(x, cos, sin):
    half = x.shape[-1] // 2
    shape = (1, x.shape[1]) + (1,) * (x.ndim - 3) + (half,)
    cs = cos.reshape(shape).astype(x.dtype)
    sn = sin.reshape(shape).astype(x.dtype)
    x1, x2 = x[..., :half], x[..., half:]
    return jnp.concatenate([x1 * cs - x2 * sn, x1 * sn + x2 * cs], axis=-1)


def project(h, w_in):
    b, n = h.shape[:2]
    qa, ka, va, ub, qc, kc, vc, qd, kd, vd = jnp.split(h @ w_in, SPLIT_IDX, axis=-1)
    return (qa.reshape(b, n, A_HEADS, HEAD_DIM), ka.reshape(b, n, A_KV_HEADS, HEAD_DIM),
            va.reshape(b, n, A_KV_HEADS, HEAD_DIM), ub,
            qc.reshape(b, n, C_HEADS, 2, C_QK_DIM), kc.reshape(b, n, C_HEADS, 2, C_QK_DIM),
            vc.reshape(b, n, C_HEADS, C_V_DIM),
            qd.reshape(b, n, D_HEADS, HEAD_DIM), kd.reshape(b, n, D_HEADS, HEAD_DIM),
            vd.reshape(b, n, D_HEADS, HEAD_DIM))


def ctx_attn(q, k, v, sink=None):
    b, l, h, d = q.shape
    g = k.shape[2]
    r = h // g
    qg = q.reshape(b, l, g, r, d)
    s = jnp.einsum('blgrd,bmgd->bgrlm', qg, k).astype(jnp.float32) * (d ** -0.5)
    if sink is not None:
        s_sink = jnp.broadcast_to(sink.astype(jnp.float32).reshape(1, g, r, 1, 1), s.shape[:-1] + (1,))
        s = jnp.concatenate([s, s_sink], axis=-1)
    p = jax.nn.softmax(s, axis=-1)[..., :l].astype(v.dtype)
    return jnp.einsum('bgrlm,bmgd->blgrd', p, v).reshape(b, l, h * d)


def window_gqa(q, k, v, kc, vc, sink):
    b, s_len, h, d = q.shape
    g = k.shape[2]
    r = h // g
    nb = s_len // BLK
    qb = q.reshape(b, nb, BLK, g, r, d)

    def band(t):
        tp = jnp.pad(t, ((0, 0), (BLK, BLK), (0, 0), (0, 0))).reshape(b, nb + 2, BLK, g, d)
        return jnp.concatenate([tp[:, :-2], tp[:, 1:-1], tp[:, 2:]], axis=2)

    kb, vb = band(k), band(v)
    scale = d ** -0.5
    s_loc = jnp.einsum('bnqgrd,bnkgd->bgrnqk', qb, kb).astype(jnp.float32) * scale
    s_ctx = jnp.einsum('bnqgrd,blgd->bgrnql', qb, kc).astype(jnp.float32) * scale
    blocks = jnp.arange(nb)[:, None, None] * BLK
    qpos = blocks + jnp.arange(BLK)[None, :, None]
    kpos = blocks + jnp.arange(3 * BLK)[None, None, :] - BLK
    valid = (jnp.abs(qpos - kpos) <= A_WINDOW) & (kpos >= 0) & (kpos < s_len)
    s_loc = jnp.where(valid, s_loc, NEG_INF)
    s_sink = jnp.broadcast_to(sink.astype(jnp.float32).reshape(1, g, r, 1, 1, 1), s_ctx.shape[:-1] + (1,))
    p = jax.nn.softmax(jnp.concatenate([s_loc, s_ctx, s_sink], axis=-1), axis=-1).astype(v.dtype)
    nk = 3 * BLK
    l = kc.shape[1]
    out = (jnp.einsum('bgrnqk,bnkgd->bnqgrd', p[..., :nk], vb)
           + jnp.einsum('bgrnql,blgd->bnqgrd', p[..., nk:nk + l], vc))
    return out.reshape(b, s_len, h * d)


def conformer_conv(u, w_dw, b_dw, ln_g, ln_b):
    a, gate = jnp.split(u, 2, axis=-1)
    h = a * jax.nn.sigmoid(gate)
    h = lax.conv_general_dilated(h, w_dw, window_strides=(1,),
                                 padding=((CONV_K // 2, CONV_K // 2),),
                                 dimension_numbers=('NWC', 'WIO', 'NWC'),
                                 feature_group_count=CONV_CH) + b_dw
    return jax.nn.silu(layernorm(h, ln_g, ln_b))


def diff_weights(q, k, v, lam):
    s = jnp.einsum('bqhmd,bkhmd->bhmqk', q, k).astype(jnp.float32) * (C_QK_DIM ** -0.5)
    p = jax.nn.softmax(s, axis=-1)
    w = (p[:, :, 0] - lam * p[:, :, 1]).astype(v.dtype)
    return jnp.einsum('bhqk,bkhd->bqhd', w, v)


def diff_out(o, subln_g, lambda_init):
    b, n, h, dv = o.shape
    return (rmsnorm(o, subln_g) * (1.0 - lambda_init)).reshape(b, n, h * dv)


def diff_attention_latent(q, k, v, kc, vc, lam):
    b, s_len = q.shape[:2]
    nb = s_len // BLK
    keys = jnp.concatenate([k, kc], axis=1)
    vals = jnp.concatenate([v, vc], axis=1)
    qb = jnp.moveaxis(q.reshape(b, nb, BLK, C_HEADS, 2, C_QK_DIM), 1, 0)
    o = lax.map(lambda qi: diff_weights(qi, keys, vals, lam), qb)
    return jnp.moveaxis(o, 0, 1).reshape(b, s_len, C_HEADS, C_V_DIM)


def neighbourhood_attn(q, k, v, kc, vc, rpb):
    b, s_len, h, d = q.shape
    rows = s_len // GRID_W
    kh = min(NA_KH, rows)
    qg = q.reshape(b, rows, GRID_W, h, d)
    kg = k.reshape(b, rows, GRID_W, h, d)
    vg = v.reshape(b, rows, GRID_W, h, d)
    r = jnp.arange(rows)
    rs = jnp.clip(r - kh // 2, 0, rows - kh)
    rows_idx = rs[:, None] + jnp.arange(kh)[None, :]
    kw_ = kg[:, rows_idx]
    vw_ = vg[:, rows_idx]
    cq = jnp.arange(GRID_W)
    cs = jnp.clip(cq - NA_KW // 2, 0, GRID_W - NA_KW)
    col_valid = (cq[None, :] >= cs[:, None]) & (cq[None, :] < cs[:, None] + NA_KW)
    dr = rows_idx - r[:, None] + (NA_KH - 1)
    dc = jnp.clip(cq[None, :] - cq[:, None], -(NA_KW - 1), NA_KW - 1) + (NA_KW - 1)
    bias = rpb.astype(jnp.float32)[:, dr[:, None, :, None], dc[None, :, None, :]]
    scale = d ** -0.5
    s_loc = jnp.einsum('brqhd,brkwhd->bhrqkw', qg, kw_).astype(jnp.float32) * scale + bias[None]
    s_loc = jnp.where(col_valid[:, None, :], s_loc, NEG_INF).reshape(b, h, rows, GRID_W, kh * GRID_W)
    s_ctx = jnp.einsum('brqhd,blhd->bhrql', qg, kc).astype(jnp.float32) * scale
    p = jax.nn.softmax(jnp.concatenate([s_loc, s_ctx], axis=-1), axis=-1).astype(v.dtype)
    nk = kh * GRID_W
    p_loc = p[..., :nk].reshape(b, h, rows, GRID_W, kh, GRID_W)
    out = (jnp.einsum('bhrqkw,brkwhd->brqhd', p_loc, vw_)
           + jnp.einsum('bhrql,blhd->brqhd', p[..., nk:], vc))
    return out.reshape(b, s_len, h * d)


def hybrid_mixer(hx, hc, w_in, w_out, sink, conv_w, conv_b, conv_ln_g, conv_ln_b,
                 lam, subln_g, lambda_init, rpb, rope_a, rope_c, ctx_out):
    qa, ka, va, ub, qc, kc, vc, qd, kd, vd = project(hx, w_in)
    qa_c, ka_c, va_c, ub_c, qc_c, kc_c, vc_c, qd_c, kd_c, vd_c = project(hc, w_in)
    qa, ka = apply_rope(qa, *rope_a), apply_rope(ka, *rope_a)
    qc, kc = apply_rope(qc, *rope_c), apply_rope(kc, *rope_c)
    y_a = window_gqa(qa, ka, va, ka_c, va_c, sink)
    y_b = conformer_conv(ub, conv_w, conv_b, conv_ln_g, conv_ln_b)
    y_c = diff_out(diff_attention_latent(qc, kc, vc, kc_c, vc_c, lam), subln_g, lambda_init)
    y_d = neighbourhood_attn(qd, kd, vd, kd_c, vd_c, rpb)
    yx = jnp.concatenate([y_a, y_b, y_c, y_d], axis=-1) @ w_out
    if not ctx_out:
        return yx, None
    yc_a = ctx_attn(qa_c, ka_c, va_c, sink)
    yc_b = conformer_conv(ub_c, conv_w, conv_b, conv_ln_g, conv_ln_b)
    yc_c = diff_out(diff_weights(qc_c, kc_c, vc_c, lam), subln_g, lambda_init)
    yc_d = ctx_attn(qd_c, kd_c, vd_c)
    yc = jnp.concatenate([yc_a, yc_b, yc_c, yc_d], axis=-1) @ w_out
    return yx, yc


def swiglu(h, w_gate, w_up, w_down):
    return (jax.nn.silu(h @ w_gate) * (h @ w_up)) @ w_down


def setup_inputs(seed: int = 0) -> dict:
    key = jax.random.key(seed)
    ks = jax.random.split(key, 25)
    nrm = lambda k, shape, s: jax.random.normal(k, shape, jnp.float32) * s
    D, F = D_MODEL, FFN_HIDDEN
    return {
        'x': nrm(ks[0], (BATCH, SEQ, D), 1.0),
        'c': nrm(ks[1], (BATCH, D), 1.0),
        'ctx': nrm(ks[2], (BATCH, CTX_LEN, D), 1.0),
        'c_ctx': nrm(ks[3], (D,), 1.0),
        'norm1_g': 1.0 + nrm(ks[4], (DEPTH, D), 0.1),
        'norm2_g': 1.0 + nrm(ks[5], (DEPTH, D), 0.1),
        'w_ada': nrm(ks[6], (DEPTH, D, 6 * D), 0.5 * D ** -0.5),
        'b_ada': nrm(ks[7], (DEPTH, 6 * D), 0.02),
        'w_in': nrm(ks[8], (DEPTH, D, IN_WIDTH), D ** -0.5),
        'w_out': nrm(ks[9], (DEPTH, MIX_WIDTH, D), MIX_WIDTH ** -0.5),
        'attn_sink': nrm(ks[10], (DEPTH, A_HEADS), 1.0),
        'conv_w': nrm(ks[11], (DEPTH, CONV_K, 1, CONV_CH), CONV_K ** -0.5),
        'conv_b': nrm(ks[12], (DEPTH, CONV_CH), 0.02),
        'conv_ln_g': 1.0 + nrm(ks[13], (DEPTH, CONV_CH), 0.1),
        'conv_ln_b': nrm(ks[14], (DEPTH, CONV_CH), 0.02),
        'diff_lq1': nrm(ks[15], (DEPTH, C_QK_DIM), 0.1),
        'diff_lk1': nrm(ks[16], (DEPTH, C_QK_DIM), 0.1),
        'diff_lq2': nrm(ks[17], (DEPTH, C_QK_DIM), 0.1),
        'diff_lk2': nrm(ks[18], (DEPTH, C_QK_DIM), 0.1),
        'diff_subln_g': 1.0 + nrm(ks[19], (DEPTH, C_V_DIM), 0.1),
        'na_rpb': nrm(ks[20], (DEPTH, D_HEADS, 2 * NA_KH - 1, 2 * NA_KW - 1), 0.1),
        'w_gate': nrm(ks[21], (DEPTH, D, F), D ** -0.5),
        'w_up': nrm(ks[22], (DEPTH, D, F), D ** -0.5),
        'w_down': nrm(ks[23], (DEPTH, F, D), F ** -0.5),
        'final_g': 1.0 + nrm(ks[24], (D,), 0.1),
    }


def reference(x, c, ctx, c_ctx, norm1_g, norm2_g, w_ada, b_ada, w_in, w_out, attn_sink,
              conv_w, conv_b, conv_ln_g, conv_ln_b, diff_lq1, diff_lk1, diff_lq2, diff_lk2,
              diff_subln_g, na_rpb, w_gate, w_up, w_down, final_g):
    s_len = x.shape[1]
    rope_a = axial_rope(s_len, HEAD_DIM)
    rope_c = axial_rope(s_len, C_QK_DIM)
    sc = jax.nn.silu(c)
    scc = jax.nn.silu(c_ctx)
    for l in range(DEPTH):
        ctx_needed = l < DEPTH - 1
        mx = sc @ w_ada[l] + b_ada[l]
        mc = scc @ w_ada[l] + b_ada[l]
        sh1, sc1, g1, sh2, sc2, g2 = jnp.split(mx[:, None, :], 6, axis=-1)
        csh1, csc1, cg1, csh2, csc2, cg2 = jnp.split(mc, 6, axis=-1)
        lambda_init = 0.8 - 0.6 * math.exp(-0.3 * l)
        lam = (jnp.exp(jnp.sum(diff_lq1[l].astype(jnp.float32) * diff_lk1[l].astype(jnp.float32)))
               - jnp.exp(jnp.sum(diff_lq2[l].astype(jnp.float32) * diff_lk2[l].astype(jnp.float32)))
               + lambda_init)
        hx = modulate(rmsnorm(x, norm1_g[l]), sh1, sc1)
        hc = modulate(rmsnorm(ctx, norm1_g[l]), csh1, csc1)
        yx, yc = hybrid_mixer(hx, hc, w_in[l], w_out[l], attn_sink[l], conv_w[l], conv_b[l],
                              conv_ln_g[l], conv_ln_b[l], lam, diff_subln_g[l], lambda_init,
                              na_rpb[l], rope_a, rope_c, ctx_needed)
        x = x + g1 * yx
        x = x + g2 * swiglu(modulate(rmsnorm(x, norm2_g[l]), sh2, sc2), w_gate[l], w_up[l], w_down[l])
        if ctx_needed:
            ctx = ctx + cg1 * yc
            ctx = ctx + cg2 * swiglu(modulate(rmsnorm(ctx, norm2_g[l]), csh2, csc2),
                                     w_gate[l], w_up[l], w_down[l])
    return rmsnorm(x, final_g)
```

```cpp
#include <hip/hip_runtime.h>
#include <hip/hip_cooperative_groups.h>
#include <cstdio>
#include <cstdint>
namespace cg = cooperative_groups;
namespace pg8 {
#define PG8_LAS __attribute__((address_space(3)))
typedef unsigned short bf16_t;
typedef _Float16 bf16x8 __attribute__((ext_vector_type(8)));
typedef float f32x4 __attribute__((ext_vector_type(4)));
typedef unsigned u32x4 __attribute__((ext_vector_type(4)));
constexpr int BM = 256, BK = 64, HALF = 128, HTB = HALF * BK * 2  , STAGE_BYTES = 8 * HTB, NXCD = 8, WGM = 8;

__host__ __device__ __forceinline__ int lds_byte(int r, int c) { const int st = (r >> 4) * 2 + (c >> 5), rr = r & 15, cc = c & 31, ob = rr * 64 + cc * 2; return st * 1024 + (ob ^ (((ob >> 9) & 1) << 5)); }
__host__ __device__ __forceinline__ void stage_rc(int b, int& R, int& C) { const int st = b / 1024, sb = b % 1024, swz = sb ^ (((sb >> 9) & 1) << 5); R = (st >> 1) * 16 + swz / 64; C = (st & 1) * 32 + (swz % 64) / 2; }
__host__ __device__ __forceinline__ int perm32(int rho) { const int n = rho >> 4, i = rho & 15; return 8 * (i >> 2) + 4 * n + (i & 3); }

struct Unit { int pm, pn, ko, nt; };
struct Gemm { const bf16_t* A; const bf16_t* Bt; int M, N, K; };

struct StaticOrder {
    int nM, nN, nwg, G, c;
    __host__ __device__ void init(int M, int N, int G_, int c_) { nM = M / BM; nN = N / BM; nwg = nM * nN; G = G_; c = c_; }
    __host__ __device__ bool next(int i, Unit& u) const {
        const long L = (long)i * G + c; if (L >= nwg) return false;
        int wgid = (int)L; { const int q = nwg / NXCD, r = nwg % NXCD, xcd = wgid % NXCD, off = wgid / NXCD; wgid = (xcd < r ? xcd * (q + 1) : r * (q + 1) + (xcd - r) * q) + off; }
        const int nig = WGM * nN, gid = wgid / nig, fm = gid * WGM, gsz = (nM - fm) < WGM ? (nM - fm) : WGM;
        u.pm = fm + ((wgid % nig) % gsz); u.pn = (wgid % nig) / gsz; u.ko = 0; u.nt = 0; return true;
    }
    __device__ __forceinline__ void a_ready(const Unit&) const {}
    __device__ __forceinline__ void done(const Unit&) const {}
};

template <class Epi, class Sched, bool ALIGN_EPI = false, bool SP2 = false>
__device__ __forceinline__ void gemm_phase(PG8_LAS unsigned char* lds, const Gemm g, const Sched& S, const Epi& E) {
    int tid_l = threadIdx.x; asm volatile("" : "+v"(tid_l));
    const int tid = tid_l, wid = __builtin_amdgcn_readfirstlane(tid >> 6), lane = tid & 63, wr = wid >> 2, wc = wid & 3, fr = lane & 15, fq = lane >> 4;
    const int K = g.K; int nt = K / BK;
    unsigned voffA[2], voffB[2];
#pragma unroll
    for (int i = 0; i < 2; ++i) { int R, C; stage_rc(tid * 16 + i * 8192, R, C); const int Rb = Epi::PERM ? ((R & ~31) + perm32(R & 31)) : R;
        voffA[i] = (unsigned)(R * K + C) * 2u; voffB[i] = (unsigned)(Rb * K + C) * 2u; }
    const size_t kstep = (size_t)(BK * 2);
    const size_t hstep = (size_t)HALF * K * 2;
    const size_t tstep = 2 * hstep;
    const unsigned ldsw = (unsigned)wid * 1024u;
    const int aoff = lds_byte(wr * 64 + fr, fq * 8), boff = lds_byte(wc * 32 + fr, fq * 8);
#define PG8_SA(b, h) (((b) * 2 + (h)) * HTB)
#define PG8_SB(b, h) ((4 + (b) * 2 + (h)) * HTB)
#define PG8_STAGE(bufoff, gbase, voff) do { _Pragma("unroll") for (int _i = 0; _i < 2; ++_i) \
        __builtin_amdgcn_global_load_lds((const unsigned*)((const char*)(gbase) + (voff)[_i]), (PG8_LAS unsigned*)(lds + (bufoff) + ldsw + _i * 8192), 16, 0, 0); } while (0)
#define PG8_LDA(dst, b, h) do { _Pragma("unroll") for (int m = 0; m < 4; ++m) _Pragma("unroll") for (int k = 0; k < 2; ++k) dst[m][k] = *(const PG8_LAS bf16x8*)(lds + PG8_SA(b, h) + aoff + m * 2048 + k * 1024); } while (0)
#define PG8_LDB(dst, b, h) do { _Pragma("unroll") for (int n = 0; n < 2; ++n) _Pragma("unroll") for (int k = 0; k < 2; ++k) dst[n][k] = *(const PG8_LAS bf16x8*)(lds + PG8_SB(b, h) + boff + n * 2048 + k * 1024); } while (0)
#define PG8_MMA(ai, bj, At, Bt) do { __builtin_amdgcn_s_setprio(1); _Pragma("unroll") for (int m = 0; m < 4; ++m) _Pragma("unroll") for (int n = 0; n < 2; ++n) _Pragma("unroll") for (int k = 0; k < 2; ++k) \
        acc[ai][bj][m][n] = __builtin_amdgcn_mfma_f32_16x16x32_f16(Bt[n][k], At[m][k], acc[ai][bj][m][n], 0, 0, 0); __builtin_amdgcn_s_setprio(0); } while (0)
#define PG8_WAIT_V(n) asm volatile("s_waitcnt vmcnt(" #n ")" ::: "memory")
#define PG8_WAIT_L(n) asm volatile("s_waitcnt lgkmcnt(" #n ")" ::: "memory")
#define PG8_BAR __builtin_amdgcn_s_barrier()
#define PG8_SCHED __builtin_amdgcn_sched_barrier(0)
    Unit cur, nxt; int ui = 0;
    if (!S.next(0, cur)) return;
    if (cur.nt) nt = cur.nt;
    f32x4 acc[2][2][4][2];
#pragma unroll
    for (int a = 0; a < 2; ++a)
#pragma unroll
        for (int b = 0; b < 2; ++b)
#pragma unroll
            for (int m = 0; m < 4; ++m)
#pragma unroll
                for (int n = 0; n < 2; ++n) acc[a][b][m][n] = (f32x4){0.f, 0.f, 0.f, 0.f};
    bf16x8 At[4][2], B0[2][2], B1[2][2];
    const char* cA = (const char*)g.A + (size_t)cur.pm * tstep + cur.ko; const char* cB = (const char*)g.Bt + (size_t)cur.pn * tstep + cur.ko;
    S.a_ready(cur);
    if constexpr (SP2) {
        PG8_STAGE(PG8_SB(0, 0), cB, voffB); PG8_STAGE(PG8_SB(0, 1), cB + hstep, voffB); PG8_STAGE(PG8_SA(0, 0), cA, voffA); PG8_STAGE(PG8_SA(0, 1), cA + hstep, voffA);
        if (wr == 1) PG8_BAR;
        PG8_WAIT_V(2); PG8_BAR;
        PG8_STAGE(PG8_SB(1, 0), cB + kstep, voffB); PG8_STAGE(PG8_SA(1, 0), cA + kstep, voffA); PG8_STAGE(PG8_SB(1, 1), cB + hstep + kstep, voffB);
        PG8_WAIT_V(6); PG8_BAR;
    } else {
        PG8_STAGE(PG8_SB(0, 0), cB, voffB); PG8_STAGE(PG8_SA(0, 0), cA, voffA); PG8_STAGE(PG8_SB(0, 1), cB + hstep, voffB); PG8_STAGE(PG8_SA(0, 1), cA + hstep, voffA);
        if (wr == 1) PG8_BAR;
        PG8_WAIT_V(4); PG8_BAR;
        PG8_STAGE(PG8_SB(1, 0), cB + kstep, voffB); PG8_STAGE(PG8_SA(1, 0), cA + kstep, voffA); PG8_STAGE(PG8_SB(1, 1), cB + hstep + kstep, voffB);
        PG8_WAIT_V(6); PG8_BAR;
    }
    for (;;) {
        const bool has_next = S.next(ui + 1, nxt);
        const char* nA = has_next ? (const char*)g.A + (size_t)nxt.pm * tstep + nxt.ko : cA; const char* nB = has_next ? (const char*)g.Bt + (size_t)nxt.pn * tstep + nxt.ko : cB;
        for (int t = 0; t < nt; t += 2) {
            const bool last = (t == nt - 2);
            const char* a1 = cA + (size_t)(t + 1) * kstep;
            const char* a2 = last ? nA : cA + (size_t)(t + 2) * kstep; const char* b2 = last ? nB : cB + (size_t)(t + 2) * kstep;
            const char* a3 = a2 + kstep; const char* b3 = b2 + kstep;
            if (last && has_next) S.a_ready(nxt);
            if constexpr (SP2) {
            PG8_LDB(B0, 0, 0); PG8_LDB(B1, 0, 1); PG8_SCHED; PG8_LDA(At, 0, 0); PG8_STAGE(PG8_SA(1, 1), a1 + hstep, voffA);
            PG8_WAIT_V(8); PG8_WAIT_L(0); PG8_BAR; PG8_MMA(0, 0, At, B0); PG8_MMA(0, 1, At, B1); PG8_BAR; PG8_SCHED;
            PG8_LDA(At, 0, 1); PG8_STAGE(PG8_SB(0, 0), b2, voffB); PG8_STAGE(PG8_SB(0, 1), b2 + hstep, voffB); PG8_STAGE(PG8_SA(0, 0), a2, voffA);
            PG8_WAIT_V(8); PG8_WAIT_L(0); PG8_BAR; PG8_MMA(1, 0, At, B0); PG8_MMA(1, 1, At, B1); PG8_BAR; PG8_SCHED;
            PG8_LDB(B0, 1, 0); PG8_LDB(B1, 1, 1); PG8_SCHED; PG8_LDA(At, 1, 0); PG8_STAGE(PG8_SA(0, 1), a2 + hstep, voffA);
            PG8_WAIT_V(8); PG8_WAIT_L(0); PG8_BAR; PG8_MMA(0, 0, At, B0); PG8_MMA(0, 1, At, B1); PG8_BAR; PG8_SCHED;
            PG8_LDA(At, 1, 1); PG8_STAGE(PG8_SB(1, 0), b3, voffB); PG8_STAGE(PG8_SB(1, 1), b3 + hstep, voffB); PG8_STAGE(PG8_SA(1, 0), a3, voffA);
            PG8_WAIT_V(8); PG8_WAIT_L(0); PG8_BAR; PG8_MMA(1, 0, At, B0); PG8_MMA(1, 1, At, B1); PG8_BAR; PG8_SCHED;
            } else {
            PG8_LDB(B0, 0, 0); PG8_SCHED; PG8_LDA(At, 0, 0); PG8_STAGE(PG8_SA(1, 1), a1 + hstep, voffA);
            PG8_WAIT_L(8); PG8_BAR; PG8_WAIT_L(0); PG8_MMA(0, 0, At, B0); PG8_BAR; PG8_SCHED;
            PG8_LDB(B1, 0, 1); PG8_STAGE(PG8_SB(0, 0), b2, voffB);
            PG8_BAR; PG8_WAIT_L(0); PG8_MMA(0, 1, At, B1); PG8_BAR;
            PG8_LDA(At, 0, 1); PG8_STAGE(PG8_SA(0, 0), a2, voffA);
            PG8_BAR; PG8_WAIT_L(0); PG8_MMA(1, 0, At, B0); PG8_BAR; PG8_SCHED;
            PG8_STAGE(PG8_SB(0, 1), b2 + hstep, voffB);
            PG8_WAIT_V(6); PG8_BAR; PG8_MMA(1, 1, At, B1); PG8_BAR;
            PG8_LDB(B0, 1, 0); PG8_SCHED; PG8_LDA(At, 1, 0); PG8_STAGE(PG8_SA(0, 1), a2 + hstep, voffA);
            PG8_WAIT_L(8); PG8_BAR; PG8_WAIT_L(0); PG8_MMA(0, 0, At, B0); PG8_BAR; PG8_SCHED;
            PG8_LDB(B1, 1, 1); PG8_STAGE(PG8_SB(1, 0), b3, voffB);
            PG8_BAR; PG8_WAIT_L(0); PG8_MMA(0, 1, At, B1); PG8_BAR;
            PG8_LDA(At, 1, 1); PG8_STAGE(PG8_SA(1, 0), a3, voffA);
            PG8_BAR; PG8_WAIT_L(0); PG8_MMA(1, 0, At, B0); PG8_BAR; PG8_SCHED;
            PG8_STAGE(PG8_SB(1, 1), b3 + hstep, voffB);
            PG8_WAIT_V(6); PG8_BAR; PG8_MMA(1, 1, At, B1); PG8_BAR;
            }
        }
        if constexpr (ALIGN_EPI) { if (wr == 0) PG8_BAR; }
        if constexpr (!Epi::AFTER_DRAIN) { E(acc, cur, wr, wc, fr, fq); S.done(cur); }
        if (!has_next) break;
#pragma unroll
        for (int a = 0; a < 2; ++a)
#pragma unroll
            for (int b = 0; b < 2; ++b)
#pragma unroll
                for (int m = 0; m < 4; ++m)
#pragma unroll
                    for (int n = 0; n < 2; ++n) acc[a][b][m][n] = (f32x4){0.f, 0.f, 0.f, 0.f};
        cur = nxt; cA = nA; cB = nB; ++ui; nt = cur.nt ? cur.nt : K / BK;
        if constexpr (ALIGN_EPI) { if (wr == 1) PG8_BAR; }
    }
    PG8_WAIT_V(0);
    if constexpr (!ALIGN_EPI) { if (wr == 0) PG8_BAR; }
    PG8_BAR;
    if constexpr (Epi::AFTER_DRAIN) { E.fused(acc, cur, wr, wc, fr, fq, lds, wid, lane); S.done(cur); }
#undef PG8_SA
#undef PG8_SB
#undef PG8_STAGE
#undef PG8_LDA
#undef PG8_LDB
#undef PG8_MMA
#undef PG8_WAIT_V
#undef PG8_WAIT_L
#undef PG8_BAR
#undef PG8_SCHED
}
}

#ifndef MK_REP_GU
#define MK_REP_GU 1
#endif
#ifndef MK_REP_IN
#define MK_REP_IN 1
#endif
#ifndef MK_REP_SYNC
#define MK_REP_SYNC 1
#endif
#ifndef MK_REP_N1
#define MK_REP_N1 1
#endif
#ifndef MK_REP_TR
#define MK_REP_TR 1
#endif
#ifndef MK_REP_ADA
#define MK_REP_ADA 1
#endif
#ifndef MK_REP_OUT
#define MK_REP_OUT 1
#endif
#ifndef MK_REP_DN
#define MK_REP_DN 1
#endif
#ifndef MK_REP_MIX
#define MK_REP_MIX 1
#endif
constexpr int DM = 1024, NB = 8, SEQ = 2048, CTXL = 256;
constexpr int MX = NB * SEQ;
constexpr int MC = NB * CTXL;
constexpr int MT = MX + MC;
constexpr int INW = 2560, FF = 2816, MODW = 6 * DM;
constexpr float EPS = 1e-6f;
constexpr float LOG2E = 1.4426950408889634f;

#define LAS __attribute__((address_space(3)))
typedef _Float16 h16;
typedef _Float16 h8 __attribute__((ext_vector_type(8)));
typedef _Float16 h4 __attribute__((ext_vector_type(4)));
typedef _Float16 h2 __attribute__((ext_vector_type(2)));
typedef float f32x4 __attribute__((ext_vector_type(4)));
typedef float f32x2 __attribute__((ext_vector_type(2)));
typedef float f32x16 __attribute__((ext_vector_type(16)));
typedef unsigned u32x4 __attribute__((ext_vector_type(4)));
typedef unsigned u32x2 __attribute__((ext_vector_type(2)));

constexpr size_t MiB = 1u << 20;
constexpr size_t WS_MOD = 0;
constexpr size_t MOD_BYTES = (size_t)2 * 9 * MODW * 4;
constexpr size_t WS_ROPEA = 1 * MiB;
constexpr size_t WS_ROPEC = 1 * MiB + 512 * 1024;
constexpr size_t WS_W = 2 * MiB, WS_WSTRIDE = 24 * MiB;
constexpr size_t WO_OFF = 5 * MiB, WGU_OFF = 7 * MiB, WD_OFF = 18 * MiB;
constexpr size_t WS_XN = 50 * MiB;
constexpr size_t WS_CR = 86 * MiB;
constexpr size_t WS_PRJ = 94 * MiB;
constexpr size_t WS_Y = 184 * MiB;
constexpr size_t WS_H = 94 * MiB;
constexpr size_t WS_END = 252 * MiB;
constexpr size_t WS_PART = 220 * MiB;
constexpr size_t WS_SSQ = 448 * 1024;
constexpr size_t SHW_OFF = 23 * MiB + 512 * 1024;
constexpr int SHWW = 8192;

constexpr int LDS_BYTES = 147456;

__device__ __forceinline__ unsigned pkh2(float lo, float hi) { h2 v = {(h16)lo, (h16)hi}; return __builtin_bit_cast(unsigned, v); }
__device__ __forceinline__ float wave_sum(float v) {
#pragma unroll
    for (int o = 1; o < 64; o <<= 1) v += __shfl_xor(v, o);
    return v;
}
__device__ __forceinline__ float ex2(float x) { return __builtin_amdgcn_exp2f(x); }
__device__ __forceinline__ float silu_f(float g) { return g * __builtin_amdgcn_rcpf(1.f + ex2(-g * LOG2E)); }

#ifndef MK_WT
#define MK_WT 0
#endif
__device__ __forceinline__ void store16_wt(void* p, u32x4 v) {
#if MK_WT
    asm volatile("global_store_dwordx4 %0, %1, off sc1\n\ts_nop 1" :: "v"(p), "v"(v) : "memory");
#else
    *(u32x4*)p = v;
#endif
}
__device__ __forceinline__ f32x4 rot4(const f32x4 v, const f32x4 cs) { f32x4 o; o[0] = v[0] * cs[0] - v[1] * cs[1]; o[1] = v[0] * cs[1] + v[1] * cs[0]; o[2] = v[2] * cs[2] - v[3] * cs[3]; o[3] = v[2] * cs[3] + v[3] * cs[2]; return o; }

constexpr int PF_OFF = 131072, PF_SLOT = 2048;
struct PrefOrder : pg8::StaticOrder {
    const float* ssq; const float* shw; LAS unsigned char* ldsb; mutable int na;
    __device__ __forceinline__ void a_ready(const pg8::Unit& u) const {
        const int w = __builtin_amdgcn_readfirstlane(threadIdx.x >> 6), lane = threadIdx.x & 63;
        const int bidx = (u.pm < 64) ? (u.pm >> 3) : 8;
        const float* gp = (w < 4) ? ssq + u.pm * 256 + w * 64 + lane : shw + bidx * SHWW + u.pn * 256 + (w - 4) * 64 + lane;
        __builtin_amdgcn_global_load_lds((const unsigned*)gp, (LAS unsigned*)(ldsb + PF_OFF + (na & 1) * PF_SLOT + w * 256), 4, 0, 0);
        na += 1;
    }
};

struct EpiInProj {
    static constexpr bool PERM = true, AFTER_DRAIN = false;
    h16* PRJ; const float2* ropeA; const float2* ropeC; LAS unsigned char* ldsb; mutable int ne;
    __device__ __forceinline__ void operator()(const f32x4 (&acc)[2][2][4][2], const pg8::Unit& u, int wr, int wc, int fr, int fq) const {
        const LAS float* slot = (const LAS float*)(ldsb + PF_OFF + (ne & 1) * PF_SLOT); ne += 1;
#pragma unroll
        for (int bj = 0; bj < 2; ++bj) {
            const int hb = 2 * u.pn + bj;
            const int col0 = hb * 128 + wc * 32 + 8 * fq;
            const f32x4 sw0 = *(const LAS f32x4*)(slot + 256 + bj * 128 + wc * 32 + 8 * fq), sw1 = *(const LAS f32x4*)(slot + 256 + bj * 128 + wc * 32 + 8 * fq + 4);
            const int ropeMode = (hb <= 2) ? 1 : ((hb >= 8 && hb <= 11) ? 2 : 0);
            const float sc = (hb <= 1 || hb == 14 || hb == 15) ? 0.125f * LOG2E : ((hb == 8 || hb == 9) ? 0.17677669529663687f * LOG2E : 1.f);
#pragma unroll
            for (int ai = 0; ai < 2; ++ai)
#pragma unroll
                for (int m = 0; m < 4; ++m) {
                    const int row = u.pm * 256 + ai * 128 + wr * 64 + m * 16 + fr;
                    const float rs = __builtin_amdgcn_rsqf(slot[ai * 128 + wr * 64 + m * 16 + fr] * (1.f / DM) + EPS);
                    f32x4 v0 = acc[ai][bj][m][0] * rs + sw0, v1 = acc[ai][bj][m][1] * rs + sw1;
                    if (ropeMode != 0 && row < MX) {
                        const int t = row & (SEQ - 1);
                        const float2* tab = (ropeMode == 1) ? ropeA + t * 32 + (((wc * 32 + 8 * fq) & 63) >> 1) : ropeC + t * 16 + 4 * fq;
                        const f32x4 c01 = *(const f32x4*)tab, c23 = *(const f32x4*)(tab + 2);
                        v0 = rot4(v0, c01); v1 = rot4(v1, c23);
                    }
                    v0 = v0 * sc; v1 = v1 * sc;
                    u32x4 w; w.x = pkh2(v0[0], v0[1]); w.y = pkh2(v0[2], v0[3]); w.z = pkh2(v1[0], v1[1]); w.w = pkh2(v1[2], v1[3]);
                    store16_wt(PRJ + (size_t)row * INW + col0, w);
                    if (m & 1) asm volatile("" ::: "memory");
                }
        }
    }
};

struct EpiResid {
    static constexpr bool PERM = false, AFTER_DRAIN = false;
    const float* srcX; const float* srcC; float* dstX; float* dstC; const float* gate;
    h16* XN; const float* ng; const float* scl; float* ssq; int emit; float gsc;
    __device__ __forceinline__ void operator()(const f32x4 (&acc)[2][2][4][2], const pg8::Unit& u, int wr, int wc, int fr, int fq) const {
        const int bidx = (u.pm < 64) ? (u.pm >> 3) : 8;
        const int colb = u.pn * 256 + wc * 32 + 4 * fq;
        f32x4 g4[2][2], gm[2][2];
#pragma unroll
        for (int bj = 0; bj < 2; ++bj)
#pragma unroll
            for (int n = 0; n < 2; ++n) { const int col = colb + bj * 128 + n * 16; g4[bj][n] = *(const f32x4*)(gate + bidx * MODW + col) * gsc;
                gm[bj][n] = emit ? *(const f32x4*)(ng + col) * (*(const f32x4*)(scl + bidx * MODW + col) + 1.f) : (f32x4){0.f, 0.f, 0.f, 0.f}; }
#ifndef MK_RB
#define MK_RB 2
#endif
#pragma unroll
        for (int t = 0; t < 8 / MK_RB; ++t) {
            f32x4 xb[MK_RB][2][2];
#pragma unroll
            for (int k = 0; k < MK_RB; ++k) {
                const int rg = t * MK_RB + k, row = u.pm * 256 + (rg >> 2) * 128 + wr * 64 + (rg & 3) * 16 + fr;
                const float* sp = (row < MX) ? srcX + (size_t)row * DM : srcC + (size_t)(row - MX) * DM;
#pragma unroll
                for (int bj = 0; bj < 2; ++bj)
#pragma unroll
                    for (int n = 0; n < 2; ++n) xb[k][bj][n] = *(const f32x4*)(sp + colb + bj * 128 + n * 16);
            }
            asm volatile("" ::: "memory");
#pragma unroll
            for (int k = 0; k < MK_RB; ++k) {
                const int rg = t * MK_RB + k, ai = rg >> 2, m = rg & 3, row = u.pm * 256 + ai * 128 + wr * 64 + m * 16 + fr;
                float* d = (row < MX) ? dstX + (size_t)row * DM : dstC + (size_t)(row - MX) * DM;
                float part = 0.f;
#pragma unroll
                for (int bj = 0; bj < 2; ++bj)
#pragma unroll
                    for (int n = 0; n < 2; ++n) {
                        const int col = colb + bj * 128 + n * 16;
                        const f32x4 x4 = xb[k][bj][n] + g4[bj][n] * acc[ai][bj][m][n];
                        *(f32x4*)(d + col) = x4;
                        if (emit) { part += (x4[0] * x4[0] + x4[1] * x4[1]) + (x4[2] * x4[2] + x4[3] * x4[3]);
                            const f32x4 o = x4 * gm[bj][n]; u32x2 w; w.x = pkh2(o[0], o[1]); w.y = pkh2(o[2], o[3]); *(u32x2*)(XN + (size_t)row * DM + col) = w; }
                    }
                if (emit) { part += __shfl_xor(part, 16); part += __shfl_xor(part, 32); if (fq == 0) unsafeAtomicAdd(ssq + row, part); }
            }
            asm volatile("" ::: "memory");
        }
    }
};

struct CtxSplitOrder {
    int G, c;
    __device__ __forceinline__ bool next(int i, pg8::Unit& u) const {
        const int L = i * G + c; if (L >= 256) return false;
        const int tile = L >> 3, ks = L & 7;
        u.pm = 64 + (tile >> 2); u.pn = tile & 3;
        const int st = (ks < 6) ? 6 * ks : 36 + 4 * (ks - 6);
        u.ko = st * 128; u.nt = (ks < 6) ? 6 : 4; return true;
    }
    __device__ __forceinline__ void a_ready(const pg8::Unit&) const {}
    __device__ __forceinline__ void done(const pg8::Unit&) const {}
};
struct EpiPartial {
    static constexpr bool PERM = true, AFTER_DRAIN = false;
    h16* PART;
    __device__ __forceinline__ void operator()(const f32x4 (&acc)[2][2][4][2], const pg8::Unit& u, int wr, int wc, int fr, int fq) const {
        const int ks = (u.ko < 36 * 128) ? u.ko / (6 * 128) : 6 + (u.ko - 36 * 128) / (4 * 128);
        h16* base = PART + (size_t)ks * MC * DM;
#pragma unroll
        for (int ai = 0; ai < 2; ++ai)
#pragma unroll
            for (int m = 0; m < 4; ++m) {
                const int row = (u.pm - 64) * 256 + ai * 128 + wr * 64 + m * 16 + fr;
#pragma unroll
                for (int bj = 0; bj < 2; ++bj) {
                    const f32x4 v0 = acc[ai][bj][m][0], v1 = acc[ai][bj][m][1];
                    u32x4 w; w.x = pkh2(v0[0], v0[1]); w.y = pkh2(v0[2], v0[3]); w.z = pkh2(v1[0], v1[1]); w.w = pkh2(v1[2], v1[3]);
                    *(u32x4*)(base + (size_t)row * DM + u.pn * 256 + bj * 128 + wc * 32 + 8 * fq) = w;
                }
            }
    }
};
__device__ __forceinline__ void ctx_fix_rows(int gw, int NGW, int lane, float* __restrict__ CR, const h16* __restrict__ PART, const float* __restrict__ gate  ,
                                             h16* __restrict__ XN, const float* __restrict__ ng, const float* __restrict__ scl  , float* __restrict__ ssq) {
    asm volatile("" : "+v"(lane));
    for (int r = gw; r < MC; r += NGW) {
        float ss = 0.f;
#pragma unroll
        for (int j = 0; j < 2; ++j) {
            const int col = 8 * (lane + 64 * j);
            f32x4 a0 = {0.f, 0.f, 0.f, 0.f}, a1 = {0.f, 0.f, 0.f, 0.f};
#pragma unroll
            for (int ks = 0; ks < 8; ++ks) { const h8 p = *(const h8*)(PART + ((size_t)ks * MC + r) * DM + col);
                a0 += (f32x4){(float)p[0], (float)p[1], (float)p[2], (float)p[3]}; a1 += (f32x4){(float)p[4], (float)p[5], (float)p[6], (float)p[7]}; }
            float* xp = CR + (size_t)r * DM + col;
            const f32x4 x0 = *(const f32x4*)xp + *(const f32x4*)(gate + col) * a0, x1 = *(const f32x4*)(xp + 4) + *(const f32x4*)(gate + col + 4) * a1;
            *(f32x4*)xp = x0; *(f32x4*)(xp + 4) = x1;
            ss += (x0[0] * x0[0] + x0[1] * x0[1]) + (x0[2] * x0[2] + x0[3] * x0[3]) + (x1[0] * x1[0] + x1[1] * x1[1]) + (x1[2] * x1[2] + x1[3] * x1[3]);
            const f32x4 o0 = x0 * *(const f32x4*)(ng + col) * (*(const f32x4*)(scl + col) + 1.f), o1 = x1 * *(const f32x4*)(ng + col + 4) * (*(const f32x4*)(scl + col + 4) + 1.f);
            u32x4 w; w.x = pkh2(o0[0], o0[1]); w.y = pkh2(o0[2], o0[3]); w.z = pkh2(o1[0], o1[1]); w.w = pkh2(o1[2], o1[3]);
            *(u32x4*)(XN + (size_t)(MX + r) * DM + col) = w;
        }
        ss = wave_sum(ss);
        if (lane == 0) ssq[MX + r] = ss;
    }
}

template <bool PLAIN> struct EpiSwigluT {
    static constexpr bool PERM = true, AFTER_DRAIN = false;
    h16* H; LAS unsigned char* ldsb; mutable int ne;
    __device__ __forceinline__ void operator()(const f32x4 (&acc)[2][2][4][2], const pg8::Unit& u, int wr, int wc, int fr, int fq) const {
        const int col0 = u.pn * 128 + wc * 32 + 8 * fq;
        const LAS float* slot = (const LAS float*)(ldsb + PF_OFF + (ne & 1) * PF_SLOT); ne += 1;
        const LAS float* sp = slot + 256 + wc * 32 + 8 * fq;
        const f32x4 sg0 = *(const LAS f32x4*)sp, sg1 = *(const LAS f32x4*)(sp + 4), su0 = *(const LAS f32x4*)(sp + 128), su1 = *(const LAS f32x4*)(sp + 132);
#pragma unroll
        for (int ai = 0; ai < 2; ++ai)
#pragma unroll
            for (int m = 0; m < 4; ++m) {
                const int row = u.pm * 256 + ai * 128 + wr * 64 + m * 16 + fr;
                const float rs = __builtin_amdgcn_rsqf(slot[ai * 128 + wr * 64 + m * 16 + fr] * (1.f / DM) + EPS);
                const f32x4 g0 = PLAIN ? acc[ai][0][m][0] : acc[ai][0][m][0] * rs + sg0, g1 = PLAIN ? acc[ai][0][m][1] : acc[ai][0][m][1] * rs + sg1, u0 = PLAIN ? acc[ai][1][m][0] : acc[ai][1][m][0] * rs + su0, u1 = PLAIN ? acc[ai][1][m][1] : acc[ai][1][m][1] * rs + su1;
                u32x4 w;
                w.x = pkh2(silu_f(g0[0]) * u0[0], silu_f(g0[1]) * u0[1]); w.y = pkh2(silu_f(g0[2]) * u0[2], silu_f(g0[3]) * u0[3]);
                w.z = pkh2(silu_f(g1[0]) * u1[0], silu_f(g1[1]) * u1[1]); w.w = pkh2(silu_f(g1[2]) * u1[2], silu_f(g1[3]) * u1[3]);
                store16_wt(H + (size_t)row * FF + col0, w);
            }
    }
};

__device__ __forceinline__ int wt_row(int map, int n) {
    if (map == 1) {
        if (n < 384) { const int d = n & 63; return (n & ~63) + 2 * (d & 31) + (d >> 5); }
        if (n >= 1024 && n < 1536) { const int d = n & 31; return (n & ~31) + 2 * (d & 15) + (d >> 4); }
        return n;
    }
    if (map == 2) return 256 * (n >> 7) + (n & 127);
    if (map == 3) return 256 * (n >> 7) + 128 + (n & 127);
    return n;
}
__device__ __forceinline__ void p0_transpose_item(const float* __restrict__ W, int K, int N, h16* __restrict__ WT, int map, LAS float* scr, int item, int lane) {
    const int nblk = N / 32, kb = item / nblk, nb = item % nblk, k0 = 64 * kb, n0 = 32 * nb;
#pragma unroll 8
    for (int i = 0; i < 32; ++i) { const int kk = 2 * i + (lane >> 5); scr[kk * 33 + (lane & 31)] = W[(size_t)(k0 + kk) * N + n0 + (lane & 31)]; }
    asm volatile("s_waitcnt lgkmcnt(0)" ::: "memory");
    const int c = lane & 7;
#pragma unroll
    for (int j = 0; j < 4; ++j) { const int n = (lane >> 3) + 8 * j; const LAS float* s = scr + (8 * c) * 33 + n;
        u32x4 o; o.x = pkh2(s[0 * 33], s[1 * 33]); o.y = pkh2(s[2 * 33], s[3 * 33]); o.z = pkh2(s[4 * 33], s[5 * 33]); o.w = pkh2(s[6 * 33], s[7 * 33]);
        *(u32x4*)(WT + (size_t)wt_row(map, n0 + n) * K + k0 + 8 * c) = o; }
    asm volatile("s_waitcnt lgkmcnt(0)" ::: "memory");
}

__device__ __forceinline__ void p0_ada_task(const float* __restrict__ cvec, const float* __restrict__ cctx, const float* __restrict__ w_ada, const float* __restrict__ b_ada,
                                            float* __restrict__ MOD, int task, int lane, const float osc) {
    const int l = task / (96 * 8), ct = (task >> 3) % 96, kc = task & 7;
    const int n = ct * 64 + lane, k0 = kc * 128;
    float a0 = 0.f, a1 = 0.f, a2 = 0.f, a3 = 0.f, a4 = 0.f, a5 = 0.f, a6 = 0.f, a7 = 0.f, a8 = 0.f;
    const float* wp = w_ada + ((size_t)l * DM + k0) * MODW + n;
    for (int hf = 0; hf < 2; ++hf) {
        const int k = k0 + 64 * hf + lane;
        const float s0 = silu_f(cvec[0 * DM + k]), s1 = silu_f(cvec[1 * DM + k]), s2 = silu_f(cvec[2 * DM + k]), s3 = silu_f(cvec[3 * DM + k]);
        const float s4 = silu_f(cvec[4 * DM + k]), s5 = silu_f(cvec[5 * DM + k]), s6 = silu_f(cvec[6 * DM + k]), s7 = silu_f(cvec[7 * DM + k]);
        const float s8 = silu_f(cctx[k]);
        float wv[64];
#pragma unroll
        for (int kk = 0; kk < 64; ++kk) wv[kk] = wp[(size_t)(64 * hf + kk) * MODW];
#define RL(x, kk) __uint_as_float((unsigned)__builtin_amdgcn_readlane((int)__float_as_uint(x), kk))
#pragma unroll
        for (int kk = 0; kk < 64; ++kk) {
            const float w = wv[kk];
            a0 += RL(s0, kk) * w; a1 += RL(s1, kk) * w; a2 += RL(s2, kk) * w; a3 += RL(s3, kk) * w; a4 += RL(s4, kk) * w;
            a5 += RL(s5, kk) * w; a6 += RL(s6, kk) * w; a7 += RL(s7, kk) * w; a8 += RL(s8, kk) * w;
        }
#undef RL
    }
    if (kc == 0) { const float bb = b_ada[l * MODW + n]; a0 += bb; a1 += bb; a2 += bb; a3 += bb; a4 += bb; a5 += bb; a6 += bb; a7 += bb; a8 += bb; }
    a0 *= osc; a1 *= osc; a2 *= osc; a3 *= osc; a4 *= osc; a5 *= osc; a6 *= osc; a7 *= osc; a8 *= osc;
    float* mp = MOD + (size_t)l * 9 * MODW + n;
    unsafeAtomicAdd(mp + 0 * MODW, a0); unsafeAtomicAdd(mp + 1 * MODW, a1); unsafeAtomicAdd(mp + 2 * MODW, a2); unsafeAtomicAdd(mp + 3 * MODW, a3); unsafeAtomicAdd(mp + 4 * MODW, a4);
    unsafeAtomicAdd(mp + 5 * MODW, a5); unsafeAtomicAdd(mp + 6 * MODW, a6); unsafeAtomicAdd(mp + 7 * MODW, a7); unsafeAtomicAdd(mp + 8 * MODW, a8);
}

__device__ __forceinline__ void prep_rows(int gw, int NGW, int lane, const float* __restrict__ srcX, const float* __restrict__ srcC, h16* __restrict__ XN,
                                          const float* __restrict__ g, const float* __restrict__ modl, int scaleoff, float* __restrict__ ssq, int M) {
    asm volatile("" : "+v"(lane));
    for (int row = gw; row < M; row += NGW) {
        const bool isx = row < MX; const int bidx = isx ? (row >> 11) : 8;
        const f32x4* s = (const f32x4*)(isx ? srcX + (size_t)row * DM : srcC + (size_t)(row - MX) * DM);
        f32x4 v[4]; float ss = 0.f;
#pragma unroll
        for (int j = 0; j < 4; ++j) { v[j] = s[lane + 64 * j]; ss += (v[j][0] * v[j][0] + v[j][1] * v[j][1]) + (v[j][2] * v[j][2] + v[j][3] * v[j][3]); }
        ss = wave_sum(ss);
        if (lane == 0) ssq[row] = ss;
        const float* mb = modl + bidx * MODW;
#pragma unroll
        for (int j = 0; j < 4; ++j) {
            const int col = 4 * (lane + 64 * j);
            const f32x4 g4 = *(const f32x4*)(g + col), sc4 = *(const f32x4*)(mb + scaleoff + col);
            const f32x4 o = v[j] * g4 * (sc4 + 1.f);
            u32x2 w; w.x = pkh2(o[0], o[1]); w.y = pkh2(o[2], o[3]);
            *(u32x2*)(XN + (size_t)row * DM + col) = w;
        }
    }
}
__device__ __forceinline__ void shw_block_task(LAS unsigned char* lds, const h16* __restrict__ Wt  , const float* __restrict__ modl, int shiftoff, float* __restrict__ shw_p0) {
    int tid_ = threadIdx.x; asm volatile("" : "+v"(tid_));
    const int tid = tid_, lane = tid & 63, w = tid >> 6;
    LAS float* sh = (LAS float*)lds;
    LAS float* red = (LAS float*)(lds + 40960);
    for (int i = tid; i < 9 * 256; i += 512) { const int b = i >> 8, c4 = (i & 255) * 4; *(LAS f32x4*)(sh + b * 1024 + c4) = *(const f32x4*)(modl + b * MODW + shiftoff + c4); }
    __syncthreads();
    float acc[9];
#pragma unroll
    for (int b = 0; b < 9; ++b) acc[b] = 0.f;
    const h16* wp = Wt + (size_t)lane * DM + 128 * w;
#pragma unroll 2
    for (int kk = 0; kk < 128; kk += 8) {
        const h8 wv = *(const h8*)(wp + kk);
        float wf[8];
#pragma unroll
        for (int e = 0; e < 8; ++e) wf[e] = (float)wv[e];
#pragma unroll
        for (int b = 0; b < 9; ++b) {
            const f32x4 s0 = *(const LAS f32x4*)(sh + b * 1024 + 128 * w + kk), s1 = *(const LAS f32x4*)(sh + b * 1024 + 128 * w + kk + 4);
            acc[b] += (s0[0] * wf[0] + s0[1] * wf[1]) + (s0[2] * wf[2] + s0[3] * wf[3]) + (s1[0] * wf[4] + s1[1] * wf[5]) + (s1[2] * wf[6] + s1[3] * wf[7]);
        }
    }
#pragma unroll
    for (int b = 0; b < 9; ++b) red[(w * 9 + b) * 64 + lane] = acc[b];
    __syncthreads();
    for (int i = tid; i < 9 * 64; i += 512) { const int b = i >> 6, r = i & 63; float d = 0.f;
#pragma unroll
        for (int ww = 0; ww < 8; ++ww) d += red[(ww * 9 + b) * 64 + r];
        shw_p0[b * SHWW + r] = d; }
    __syncthreads();
}
__device__ __forceinline__ void final_norm_rows(int gw, int NGW, int lane, float* __restrict__ X, const float* __restrict__ g) {
    asm volatile("" : "+v"(lane));
    for (int row = gw; row < MX; row += NGW) {
        f32x4* s = (f32x4*)(X + (size_t)row * DM);
        f32x4 v[4]; float ss = 0.f;
#pragma unroll
        for (int j = 0; j < 4; ++j) { v[j] = s[lane + 64 * j]; ss += (v[j][0] * v[j][0] + v[j][1] * v[j][1]) + (v[j][2] * v[j][2] + v[j][3] * v[j][3]); }
        const float r = 1.0f / sqrtf(wave_sum(ss) * (1.f / DM) + EPS);
#pragma unroll
        for (int j = 0; j < 4; ++j) { const f32x4 g4 = *(const f32x4*)(g + 4 * (lane + 64 * j)); s[lane + 64 * j] = (v[j] * r) * g4; }
    }
}

constexpr int KROW = 144;
constexpr int KT_BYTES = 64 * KROW;
constexpr int ATT_BIAS_OFF = 4 * KT_BYTES;

__device__ __forceinline__ float max3f(float a, float b, float c) { float r; asm("v_max3_f32 %0, %1, %2, %3" : "=v"(r) : "v"(a), "v"(b), "v"(c)); return r; }
__device__ __forceinline__ float xmax32(float v) { auto rr = __builtin_amdgcn_permlane32_swap(__float_as_uint(v), __float_as_uint(v), false, false); return fmaxf(__uint_as_float(rr[0]), __uint_as_float(rr[1])); }
__device__ __forceinline__ float xsum32(float v) { auto rr = __builtin_amdgcn_permlane32_swap(__float_as_uint(v), __float_as_uint(v), false, false); return __uint_as_float(rr[0]) + __uint_as_float(rr[1]); }
constexpr float SM_THR = 8.f;
__device__ __forceinline__ void softmax_step(f32x16& s0, f32x16& s1, float& mh, float& l, f32x16& ng, f32x16 (&O)[2], const bool first, h8 (&p)[4]) {
    float mx = max3f(s0[0], s1[0], s0[1]);
    mx = max3f(mx, s1[1], s0[2]); mx = max3f(mx, s1[2], s0[3]); mx = max3f(mx, s1[3], s0[4]); mx = max3f(mx, s1[4], s0[5]);
    mx = max3f(mx, s1[5], s0[6]); mx = max3f(mx, s1[6], s0[7]); mx = max3f(mx, s1[7], s0[8]); mx = max3f(mx, s1[8], s0[9]);
    mx = max3f(mx, s1[9], s0[10]); mx = max3f(mx, s1[10], s0[11]); mx = max3f(mx, s1[11], s0[12]); mx = max3f(mx, s1[12], s0[13]);
    mx = max3f(mx, s1[13], s0[14]); mx = max3f(mx, s1[14], s0[15]); mx = fmaxf(mx, s1[15]);
    mx = xmax32(mx);
    if (__builtin_expect(first || __any(mx > SM_THR), 0)) {
        asm volatile("" ::: "memory");
        const float dl = first ? mx : fmaxf(mx, 0.f);
        mh += dl;
#pragma unroll
        for (int r = 0; r < 16; ++r) { s0[r] -= dl; s1[r] -= dl; ng[r] = -mh; }
        if (!first) { const float f = ex2(-dl); l *= f; O[0] = O[0] * f; O[1] = O[1] * f; }
    }
    f32x2 acc = {0.f, 0.f};
#pragma unroll
    for (int r = 0; r < 16; r += 2) { s0[r] = ex2(s0[r]); s0[r + 1] = ex2(s0[r + 1]); s1[r] = ex2(s1[r]); s1[r + 1] = ex2(s1[r + 1]);
        acc += (f32x2){s0[r], s0[r + 1]}; acc += (f32x2){s1[r], s1[r + 1]}; }
    l += acc[0] + acc[1];
#pragma unroll
    for (int e = 0; e < 8; ++e) { p[0][e] = (h16)s0[e]; p[1][e] = (h16)s0[8 + e]; p[2][e] = (h16)s1[e]; p[3][e] = (h16)s1[8 + e]; }
}

__device__ __forceinline__ void softmax_step_raw(f32x16& s0, f32x16& s1, float& mh, float& l, f32x16 (&O)[2], const bool first, h8 (&p)[4]) {
    float mx = max3f(s0[0], s1[0], s0[1]);
    mx = max3f(mx, s1[1], s0[2]); mx = max3f(mx, s1[2], s0[3]); mx = max3f(mx, s1[3], s0[4]); mx = max3f(mx, s1[4], s0[5]);
    mx = max3f(mx, s1[5], s0[6]); mx = max3f(mx, s1[6], s0[7]); mx = max3f(mx, s1[7], s0[8]); mx = max3f(mx, s1[8], s0[9]);
    mx = max3f(mx, s1[9], s0[10]); mx = max3f(mx, s1[10], s0[11]); mx = max3f(mx, s1[11], s0[12]); mx = max3f(mx, s1[12], s0[13]);
    mx = max3f(mx, s1[13], s0[14]); mx = max3f(mx, s1[14], s0[15]); mx = fmaxf(mx, s1[15]);
    mx = xmax32(mx) - mh;
    if (__builtin_expect(first || __any(mx > SM_THR), 0)) {
        asm volatile("" ::: "memory");
        const float dl = first ? mx : fmaxf(mx, 0.f);
        mh += dl;
        if (!first) { const float f = ex2(-dl); l *= f; O[0] = O[0] * f; O[1] = O[1] * f; }
    }
    f32x2 acc = {0.f, 0.f};
#pragma unroll
    for (int r = 0; r < 16; r += 2) { s0[r] = ex2(s0[r] - mh); s0[r + 1] = ex2(s0[r + 1] - mh); s1[r] = ex2(s1[r] - mh); s1[r + 1] = ex2(s1[r + 1] - mh);
        acc += (f32x2){s0[r], s0[r + 1]}; acc += (f32x2){s1[r], s1[r + 1]}; }
    l += acc[0] + acc[1];
#pragma unroll
    for (int e = 0; e < 8; ++e) { p[0][e] = (h16)s0[e]; p[1][e] = (h16)s0[8 + e]; p[2][e] = (h16)s1[e]; p[3][e] = (h16)s1[8 + e]; }
}

template <int SK> __device__ __forceinline__ void softmax_step_sk(f32x16& s0, f32x16& s1, float& mh, float& l, f32x16& ng, f32x16 (&O)[2], h8 (&p)[4]) {
    int im = (int)0x80000000;
#pragma unroll
    for (int r = 0; r < 16; ++r) { if (!(SK == 0 && r < 8)) im = max(im, __float_as_int(s0[r])); if (!(SK == 3 && r >= 8)) im = max(im, __float_as_int(s1[r])); }
    { auto rr = __builtin_amdgcn_permlane32_swap((unsigned)im, (unsigned)im, false, false); im = max((int)rr[0], (int)rr[1]); }
    const float mx = __int_as_float(im);
    if (__builtin_expect(__any(mx > SM_THR), 0)) {
        asm volatile("" ::: "memory");
        const float dl = fmaxf(mx, 0.f);
        mh += dl;
#pragma unroll
        for (int r = 0; r < 16; ++r) { s0[r] -= dl; s1[r] -= dl; ng[r] = -mh; }
        const float f = ex2(-dl); l *= f; O[0] = O[0] * f; O[1] = O[1] * f;
    }
    float a0 = 0.f, a1 = 0.f;
#pragma unroll
    for (int r = 0; r < 16; ++r) { if (!(SK == 0 && r < 8)) { s0[r] = ex2(s0[r]); a0 += s0[r]; } if (!(SK == 3 && r >= 8)) { s1[r] = ex2(s1[r]); a1 += s1[r]; } }
    l += a0 + a1;
#pragma unroll
    for (int e = 0; e < 8; ++e) { if (SK != 0) p[0][e] = (h16)s0[e]; p[1][e] = (h16)s0[8 + e]; p[2][e] = (h16)s1[e]; if (SK != 3) p[3][e] = (h16)s1[8 + e]; }
}

template <int MODE>
__device__ __forceinline__ void attn_unit(LAS unsigned char* lds, const h16* __restrict__ PRJ, h16* __restrict__ Y, const int b, const int sub, const int blk, const bool ctxq,
                                          const float* __restrict__ sinkp, const float* __restrict__ rpb, const float lam, const float lam_init, const float* __restrict__ subg) {
    int tid_ = threadIdx.x; asm volatile("" : "+v"(tid_));
    const int tid = tid_, lane = tid & 63, wid = __builtin_amdgcn_readfirstlane(tid >> 6), q = lane & 31, hi = lane >> 5;
    int qrow0 = 0, qcol = 0, kcol = 0, vcol = 0, ycol = 0, lt0 = 0, lt1 = 0, qpos0 = 0, rsq = 0, qr = 0; float sinkv = 0.f;
    const int ctxrow0 = MX + b * CTXL, latrow0 = b * SEQ;
    if (MODE == 0) {
        int head;
        if (!ctxq) { const int g = sub; head = 2 * g + (wid >> 2); qpos0 = 128 * blk + 32 * (wid & 3); qrow0 = latrow0 + qpos0; lt0 = max(0, 2 * (blk - 1)); lt1 = min(32, 2 * (blk + 2)); kcol = 256 + 64 * g; vcol = 384 + 64 * g; }
        else { head = sub; qrow0 = ctxrow0 + 32 * wid; kcol = 256 + 64 * (head >> 1); vcol = 384 + 64 * (head >> 1); }
        qcol = 64 * head; ycol = 64 * head; sinkv = sinkp[head] * LOG2E;
    } else if (MODE == 1) {
        const int h = sub; qcol = 1024 + 64 * h; kcol = 1280 + 64 * h; vcol = 1536 + 64 * h; ycol = 512 + 64 * h;
        if (!ctxq) { qpos0 = 256 * blk + 32 * wid; qrow0 = latrow0 + qpos0; lt0 = 0; lt1 = 32; } else { qrow0 = ctxrow0 + 32 * wid; }
    } else {
        const int h = sub; qcol = 1792 + 64 * h; kcol = 2048 + 64 * h; vcol = 2304 + 64 * h; ycol = 768 + 64 * h;
        if (!ctxq) { const int r0 = 4 * blk; qr = r0 + (wid >> 1); qpos0 = 64 * qr + 32 * (wid & 1); qrow0 = latrow0 + qpos0; rsq = min(max(qr - 4, 0), 24);
                     lt0 = min(max(r0 - 4, 0), 24); lt1 = min(max(r0 - 1, 0), 24) + 8; }
        else { qrow0 = ctxrow0 + 32 * wid; }
    }
    const int nt = 4 + (lt1 - lt0);
    LAS float* bl = (LAS float*)(lds + ATT_BIAS_OFF);
    if (MODE == 2 && !ctxq) { for (int i = tid; i < 465; i += 512) bl[i] = rpb[sub * 465 + i] * LOG2E; }
    unsigned dvm = 0u; int dboff = 0;
    if (MODE == 2) { const int qc = (qpos0 + q) & 63, cs = min(max(qc - 8, 0), 48); dboff = 4 * (8 * hi - qc + 15);
#pragma unroll
        for (int e = 0; e < 32; ++e) { const int kc = 32 * (e >> 4) + 16 * ((e & 15) >> 3) + (e & 7) + 8 * hi; if (kc >= cs && kc < cs + 16) dvm |= 1u << e; } }

    h8 qf[4];
#pragma unroll
    for (int c = 0; c < 4; ++c) qf[c] = *(const h8*)(PRJ + (size_t)(qrow0 + q) * INW + qcol + 16 * c + 8 * hi);

    const int skr = tid >> 3, skc = tid & 7, svk = tid & 63, svd = tid >> 6;
    u32x4 kreg, vreg;
#define ATT_LOAD(j) do { const int krow0_ = ((j) < 4) ? ctxrow0 + 64 * (j) : latrow0 + 64 * (lt0 + (j) - 4); \
        kreg = *(const u32x4*)(PRJ + (size_t)(krow0_ + skr) * INW + kcol + 8 * skc); vreg = *(const u32x4*)(PRJ + (size_t)(krow0_ + svk) * INW + vcol + 8 * svd); } while (0)
#define ATT_STORE(bufi) do { LAS unsigned char* kb_ = lds + (bufi) * 2 * KT_BYTES; *(LAS u32x4*)(kb_ + skr * KROW + skc * 16) = kreg; \
        LAS unsigned short* vb_ = (LAS unsigned short*)(kb_ + KT_BYTES + (8 * svd) * KROW) + svk; \
        vb_[0 * (KROW / 2)] = (unsigned short)(vreg.x & 0xffffu); vb_[1 * (KROW / 2)] = (unsigned short)(vreg.x >> 16); \
        vb_[2 * (KROW / 2)] = (unsigned short)(vreg.y & 0xffffu); vb_[3 * (KROW / 2)] = (unsigned short)(vreg.y >> 16); \
        vb_[4 * (KROW / 2)] = (unsigned short)(vreg.z & 0xffffu); vb_[5 * (KROW / 2)] = (unsigned short)(vreg.z >> 16); \
        vb_[6 * (KROW / 2)] = (unsigned short)(vreg.w & 0xffffu); vb_[7 * (KROW / 2)] = (unsigned short)(vreg.w >> 16); } while (0)
    ATT_LOAD(0); ATT_STORE(0);
    __syncthreads();

    float m1 = 0.f, l1 = 0.f, m2 = 0.f, l2 = 0.f;
    f32x16 O1[2], O2[2], ng1 = f32x16{};
#pragma unroll
    for (int dt = 0; dt < 2; ++dt) { O1[dt] = f32x16{}; O2[dt] = f32x16{}; }
    const int pi = (q & ~12) | ((q & 4) << 1) | ((q & 8) >> 1);

    for (int j = 0; j < nt; ++j) {
        if (j + 1 < nt) ATT_LOAD(j + 1);
        const LAS unsigned char* Kb = lds + (j & 1) * 2 * KT_BYTES; const LAS unsigned char* Vb = Kb + KT_BYTES;
        bool active = true; int kr = 0;
        if (MODE == 2 && j >= 4) { kr = lt0 + j - 4; active = (kr >= rsq) && (kr < rsq + 8); }
        if (active) {
            const LAS unsigned char* kp = Kb + pi * KROW + hi * 16;
            h8 p1[4];
            const LAS unsigned char* vp = Vb + q * KROW + hi * 16;
            {
                f32x16 sA[2];
#pragma unroll
                for (int hf = 0; hf < 2; ++hf) {
#pragma unroll
                    for (int c = 0; c < (MODE == 1 ? 2 : 4); ++c) {
                        const h8 kf = *(const LAS h8*)(kp + hf * 32 * KROW + c * 32);
                        if (c == 0) sA[hf] = (MODE == 1) ? __builtin_amdgcn_mfma_f32_32x32x16_f16(kf, qf[c], f32x16{}, 0, 0, 0) : __builtin_amdgcn_mfma_f32_32x32x16_f16(kf, qf[c], ng1, 0, 0, 0);
                        else sA[hf] = __builtin_amdgcn_mfma_f32_32x32x16_f16(kf, qf[c], sA[hf], 0, 0, 0);
                    }
                }
                if (j >= 4) {
                    if (MODE == 0) {
                        const int dq = qpos0 + q - 64 * (lt0 + j - 4) - 8 * hi;
#pragma unroll
                        for (int hf = 0; hf < 2; ++hf)
#pragma unroll
                            for (int r = 0; r < 16; ++r) { const int df = dq - (32 * hf + 16 * (r >> 3) + (r & 7)); if (df > 128 || df < -128) sA[hf][r] = -1e30f; }
                    }
                }
                if (MODE == 2 && j >= 4) {
                    const LAS unsigned char* bb = (const LAS unsigned char*)bl + (kr - qr + 7) * 124 + dboff;
                    constexpr int NEGB = (int)0xF149F2CAu;
                    unsigned dv = dvm; asm volatile("" : "+v"(dv));
#define D_LATENT(SK) do { \
                    _Pragma("unroll") for (int hf = 0; hf < 2; ++hf) _Pragma("unroll") for (int r = 0; r < 16; ++r) { \
                        if (!((SK) == 0 && hf == 0 && r < 8) && !((SK) == 3 && hf == 1 && r >= 8)) { const float bv = *(const LAS float*)(bb + 4 * (32 * hf + 16 * (r >> 3) + (r & 7))); \
                            const int M = ((int)(dv << (31 - (hf * 16 + r)))) >> 31; sA[hf][r] = __int_as_float((__float_as_int(sA[hf][r] + bv) & M) | (NEGB & ~M)); } } \
                    softmax_step_sk<SK>(sA[0], sA[1], m1, l1, ng1, O1, p1); \
                    _Pragma("unroll") for (int dt = 0; dt < 2; ++dt) _Pragma("unroll") for (int c = 0; c < 4; ++c) { if (c != (SK)) { \
                        const h8 vf = *(const LAS h8*)(vp + dt * 32 * KROW + c * 32); O1[dt] = __builtin_amdgcn_mfma_f32_32x32x16_f16(vf, p1[c], O1[dt], 0, 0, 0); } } } while (0)
                    if ((wid & 1) == 0) D_LATENT(3); else D_LATENT(0);
#undef D_LATENT
                } else {
                if (MODE == 1) softmax_step_raw(sA[0], sA[1], m1, l1, O1, j == 0, p1); else softmax_step(sA[0], sA[1], m1, l1, ng1, O1, j == 0, p1);
#pragma unroll
            for (int dt = 0; dt < 2; ++dt)
#pragma unroll
                for (int c = 0; c < 4; ++c) {
                    const h8 vf = *(const LAS h8*)(vp + dt * 32 * KROW + c * 32);
                    O1[dt] = __builtin_amdgcn_mfma_f32_32x32x16_f16(vf, p1[c], O1[dt], 0, 0, 0);
                }
                }
            }
            if (MODE == 1) {
                __builtin_amdgcn_sched_barrier(0);
                f32x16 sB[2]; h8 p2[4];
#pragma unroll
                for (int hf = 0; hf < 2; ++hf) {
#pragma unroll
                    for (int c = 2; c < 4; ++c) {
                        const h8 kf = *(const LAS h8*)(kp + hf * 32 * KROW + c * 32);
                        if (c == 2) sB[hf] = __builtin_amdgcn_mfma_f32_32x32x16_f16(kf, qf[c], f32x16{}, 0, 0, 0);
                        else sB[hf] = __builtin_amdgcn_mfma_f32_32x32x16_f16(kf, qf[c], sB[hf], 0, 0, 0);
                    }
                }
                softmax_step_raw(sB[0], sB[1], m2, l2, O2, j == 0, p2);
#pragma unroll
                for (int dt = 0; dt < 2; ++dt)
#pragma unroll
                    for (int c = 0; c < 4; ++c) {
                        const h8 vf = *(const LAS h8*)(vp + dt * 32 * KROW + c * 32);
                        O2[dt] = __builtin_amdgcn_mfma_f32_32x32x16_f16(vf, p2[c], O2[dt], 0, 0, 0);
                    }
            }
        }
        if (j + 1 < nt) ATT_STORE((j + 1) & 1);
        __syncthreads();
    }
#undef ATT_LOAD
#undef ATT_STORE
    h16* yrow = Y + (size_t)(qrow0 + q) * DM + ycol;
    if (MODE != 1) {
        float lt = xsum32(l1);
        if (MODE == 0) lt += ex2(sinkv - m1);
        const float inv = 1.f / lt;
#pragma unroll
        for (int dt = 0; dt < 2; ++dt)
#pragma unroll
            for (int g4 = 0; g4 < 4; ++g4) { u32x2 w; w.x = pkh2(O1[dt][4 * g4] * inv, O1[dt][4 * g4 + 1] * inv); w.y = pkh2(O1[dt][4 * g4 + 2] * inv, O1[dt][4 * g4 + 3] * inv);
                *(u32x2*)(yrow + 32 * dt + 8 * g4 + 4 * hi) = w; }
    } else {
        const float i1 = 1.f / xsum32(l1), i2 = lam / xsum32(l2);
        float ss = 0.f;
#pragma unroll
        for (int dt = 0; dt < 2; ++dt)
#pragma unroll
            for (int r = 0; r < 16; ++r) { const float o = O1[dt][r] * i1 - O2[dt][r] * i2; O1[dt][r] = o; ss += o * o; }
        ss = xsum32(ss);
        const float rr = __builtin_amdgcn_rsqf(ss * (1.f / 64.f) + EPS) * (1.f - lam_init);
#pragma unroll
        for (int dt = 0; dt < 2; ++dt)
#pragma unroll
            for (int g4 = 0; g4 < 4; ++g4) { const int d0 = 32 * dt + 8 * g4 + 4 * hi; const f32x4 sg = *(const f32x4*)(subg + d0);
                u32x2 w; w.x = pkh2(O1[dt][4 * g4] * rr * sg[0], O1[dt][4 * g4 + 1] * rr * sg[1]); w.y = pkh2(O1[dt][4 * g4 + 2] * rr * sg[2], O1[dt][4 * g4 + 3] * rr * sg[3]);
                *(u32x2*)(yrow + d0) = w; }
    }
}

__device__ __forceinline__ void conv_unit(LAS unsigned char* lds, const h16* __restrict__ PRJ, h16* __restrict__ Y, int seqrow0, int seqlen, int t0,
                                          const float* __restrict__ cw, const float* __restrict__ cb, const float* __restrict__ lg, const float* __restrict__ lb) {
    int tid_ = threadIdx.x; asm volatile("" : "+v"(tid_));
    const int tid = tid_, lane = tid & 63, wid = tid >> 6;
    LAS float* hb = (LAS float*)lds;
    LAS float* ob = hb + 62 * 256;
    for (int task = tid; task < 62 * 32; task += 512) {
        const int r = task >> 5, c8 = (task & 31) * 8, t = t0 - 15 + r;
        f32x4 o0 = {0.f, 0.f, 0.f, 0.f}, o1 = {0.f, 0.f, 0.f, 0.f};
        if (t >= 0 && t < seqlen) {
            const h16* rp = PRJ + (size_t)(seqrow0 + t) * INW + 512 + c8;
            const h8 a = *(const h8*)rp, g = *(const h8*)(rp + 256);
#pragma unroll
            for (int e = 0; e < 4; ++e) { o0[e] = (float)a[e] * __builtin_amdgcn_rcpf(1.f + ex2(-(float)g[e] * LOG2E)); o1[e] = (float)a[4 + e] * __builtin_amdgcn_rcpf(1.f + ex2(-(float)g[4 + e] * LOG2E)); }
        }
        *(LAS f32x4*)(hb + r * 256 + c8) = o0; *(LAS f32x4*)(hb + r * 256 + c8 + 4) = o1;
    }
    __syncthreads();
    {
        const int c = tid & 255, th = tid >> 8;
        float w[31];
#pragma unroll
        for (int k = 0; k < 31; ++k) w[k] = cw[k * 256 + c];
        float acc[16];
        const float bias = cb[c];
#pragma unroll
        for (int o = 0; o < 16; ++o) acc[o] = bias;
#pragma unroll
        for (int ir = 0; ir < 46; ++ir) {
            const float v = hb[(16 * th + ir) * 256 + c];
#pragma unroll
            for (int o = 0; o < 16; ++o) { const int k = ir - o; if (k >= 0 && k < 31) acc[o] += v * w[k]; }
        }
#pragma unroll
        for (int o = 0; o < 16; ++o) ob[(16 * th + o) * 256 + c] = acc[o];
    }
    __syncthreads();
#pragma unroll
    for (int tt = 0; tt < 4; ++tt) {
        const int tok = 4 * wid + tt;
        const f32x4 v = *(const LAS f32x4*)(ob + tok * 256 + 4 * lane);
        const float mean = wave_sum((v[0] + v[1]) + (v[2] + v[3])) * (1.f / 256.f);
        const f32x4 d = v - mean;
        const float var = wave_sum((d[0] * d[0] + d[1] * d[1]) + (d[2] * d[2] + d[3] * d[3])) * (1.f / 256.f);
        const float rstd = __builtin_amdgcn_rsqf(var + EPS);
        const f32x4 g4 = *(const f32x4*)(lg + 4 * lane), b4 = *(const f32x4*)(lb + 4 * lane);
        const f32x4 o = d * rstd * g4 + b4;
        u32x2 wv; wv.x = pkh2(silu_f(o[0]), silu_f(o[1])); wv.y = pkh2(silu_f(o[2]), silu_f(o[3]));
        *(u32x2*)(Y + (size_t)(seqrow0 + t0 + tok) * DM + 256 + 4 * lane) = wv;
    }
    __syncthreads();
}

constexpr size_t WS_BAR = 768 * 1024;
#define XB_TMO      128
#define XB_XCNT(j)  (256  + 64 * (j))
#define XB_XSUB(j)  (1280 + 64 * (j))
#define XB_XGEN(j)  (2304 + 64 * (j))
#define XB_TOP      3328
#define XB_TOPGEN   3392
#define XCD_BAR_WORDS 3456
#define XB_SPIN_CAP (1u << 18)

__device__ __forceinline__ unsigned xb_ld(unsigned* p)              { return __hip_atomic_load(p, __ATOMIC_RELAXED, __HIP_MEMORY_SCOPE_AGENT); }
__device__ __forceinline__ unsigned xb_add(unsigned* p, unsigned v) { return __hip_atomic_fetch_add(p, v, __ATOMIC_RELAXED, __HIP_MEMORY_SCOPE_AGENT); }
__device__ __forceinline__ unsigned xb_xcc_id() { return (unsigned)__builtin_amdgcn_s_getreg((3 << 11) | 20) & 0xFu; }
#define XB_SPIN(cond, bar) do { unsigned _sp = 0; while (cond) { __builtin_amdgcn_s_sleep(1); \
    if ((++_sp & 255u) == 0u) { if (xb_ld(&(bar)[XB_TMO])) break; if (_sp > XB_SPIN_CAP) { atomicAdd(&(bar)[XB_TMO], 1u); break; } } } } while (0)

struct XcdBarrier {
    unsigned* bar; unsigned x;
    volatile LAS unsigned* st;
};

__device__ __forceinline__ XcdBarrier xcd_barrier_post(unsigned* bar, volatile LAS unsigned* st) {
    XcdBarrier b; b.bar = bar; b.x = xb_xcc_id(); b.st = st;
    if (threadIdx.x == 0) (void)xb_add(&bar[XB_XCNT(b.x)], 1u);
    return b;
}
__device__ __forceinline__ void xcd_barrier_complete(unsigned* bar, unsigned x, unsigned& nloc, unsigned& nx) {
    const unsigned G = gridDim.x * gridDim.y * gridDim.z;
    unsigned sum, cnt, mine, sp = 0u;
    for (;;) {
        sum = 0u; cnt = 0u; mine = 0u;
#pragma unroll
        for (unsigned j = 0; j < 16; ++j) { const unsigned c = xb_ld(&bar[XB_XCNT(j)]); sum += c; cnt += (c > 0u) ? 1u : 0u; mine = (j == x) ? c : mine; }
        if (sum == G) break;
        __builtin_amdgcn_s_sleep(1);
        if ((++sp & 255u) == 0u) { if (xb_ld(&bar[XB_TMO])) break; if (sp > XB_SPIN_CAP) { atomicAdd(&bar[XB_TMO], 1u); break; } }
    }
    nloc = mine > 0u ? mine : 1u; nx = cnt > 0u ? cnt : 1u;
}

__device__ __forceinline__ void xcd_barrier(const XcdBarrier& b) {
    asm volatile("s_waitcnt vmcnt(0)" ::: "memory");
    __syncthreads();
    if (threadIdx.x == 0) {
        unsigned* bar = b.bar;
        __builtin_amdgcn_s_waitcnt(0);
        unsigned nloc = b.st[0], nx = b.st[1];
        if (nloc == 0u) { xcd_barrier_complete(bar, b.x, nloc, nx); b.st[0] = nloc; b.st[1] = nx; }
        const unsigned old = xb_add(&bar[XB_XSUB(b.x)], 1u);
        const unsigned gen = old / nloc;
        if (old + 1u == (gen + 1u) * nloc) {
            __builtin_amdgcn_fence(__ATOMIC_RELEASE, "agent");
            asm volatile("s_waitcnt vmcnt(0)" ::: "memory");
            const unsigned og = xb_add(&bar[XB_TOP], 1u);
            const unsigned tg = og / nx;
            if (og + 1u == (tg + 1u) * nx) xb_add(&bar[XB_TOPGEN], 1u);
            else XB_SPIN(xb_ld(&bar[XB_TOPGEN]) == tg, bar);
            __builtin_amdgcn_fence(__ATOMIC_ACQUIRE, "agent");
            xb_add(&bar[XB_XGEN(b.x)], 1u);
            asm volatile("s_waitcnt vmcnt(0)" ::: "memory");
        } else {
            XB_SPIN(xb_ld(&bar[XB_XGEN(b.x)]) == gen, bar);
            __builtin_amdgcn_fence(__ATOMIC_ACQUIRE, "agent");
            asm volatile("s_waitcnt vmcnt(0)" ::: "memory");
        }
    }
    __syncthreads();
}

__device__ __forceinline__ void weight_item(int r, const float* __restrict__ wi, const float* __restrict__ wo, const float* __restrict__ wg, const float* __restrict__ wu, const float* __restrict__ wd,
                                            unsigned char* wb, LAS float* scr, int lane) {
    constexpr int I_IN = 16 * 80, I_OUT = 16 * 32, I_G = 16 * 88;
    if (r < I_IN) { p0_transpose_item(wi, DM, INW, (h16*)wb, 1, scr, r, lane); return; } r -= I_IN;
    if (r < I_OUT) { p0_transpose_item(wo, DM, DM, (h16*)(wb + WO_OFF), 0, scr, r, lane); return; } r -= I_OUT;
    if (r < I_G) { p0_transpose_item(wg, DM, FF, (h16*)(wb + WGU_OFF), 2, scr, r, lane); return; } r -= I_G;
    if (r < I_G) { p0_transpose_item(wu, DM, FF, (h16*)(wb + WGU_OFF), 3, scr, r, lane); return; } r -= I_G;
    p0_transpose_item(wd, FF, DM, (h16*)(wb + WD_OFF), 0, scr, r, lane);
}
constexpr int W_ITEMS = 16 * 80 + 16 * 32 + 2 * 16 * 88 + 44 * 32;

struct Args { const float* in[25]; float* out; unsigned char* ws; int ph_lo, ph_hi; };
constexpr int N_PHASES = 15;
constexpr int N_PHASES_OLD_ = 13;

__global__ void __launch_bounds__(512, 2) mega_fwd(Args a) {
    extern __shared__ __attribute__((aligned(16))) unsigned char lds_raw[];
    LAS unsigned char* lds = (LAS unsigned char*)lds_raw;
    cg::grid_group grid = cg::this_grid();
    int tid = threadIdx.x, lane = tid & 63; const int wave = __builtin_amdgcn_readfirstlane(tid >> 6);
    const int G = gridDim.x, blk = blockIdx.x;
    const int gw = blk * 8 + wave, NGW = G * 8;
    unsigned char* ws = a.ws;
    int zq = 0;
#define ZQ() asm volatile("" : "+s"(zq), "+v"(tid), "+v"(lane))
#define x_in (a.in[0 + zq])
#define c_in (a.in[1 + zq])
#define ctx_in (a.in[2 + zq])
#define cctx_in (a.in[3 + zq])
#define norm1_g (a.in[4 + zq])
#define norm2_g (a.in[5 + zq])
#define w_ada (a.in[6 + zq])
#define b_ada (a.in[7 + zq])
#define w_in (a.in[8 + zq])
#define w_out (a.in[9 + zq])
#define attn_sink (a.in[10 + zq])
#define conv_w (a.in[11 + zq])
#define conv_b (a.in[12 + zq])
#define conv_ln_g (a.in[13 + zq])
#define conv_ln_b (a.in[14 + zq])
#define lq1 (a.in[15 + zq])
#define lk1 (a.in[16 + zq])
#define lq2 (a.in[17 + zq])
#define lk2 (a.in[18 + zq])
#define subln_g (a.in[19 + zq])
#define na_rpb (a.in[20 + zq])
#define w_gate (a.in[21 + zq])
#define w_up (a.in[22 + zq])
#define w_down (a.in[23 + zq])
#define final_g (a.in[24 + zq])
    float* XO = a.out;
    float* MOD = (float*)(ws + WS_MOD);
    float2* ropeA = (float2*)(ws + WS_ROPEA); float2* ropeC = (float2*)(ws + WS_ROPEC);
    h16* XN = (h16*)(ws + WS_XN); float* CR = (float*)(ws + WS_CR); h16* PRJ = (h16*)(ws + WS_PRJ); h16* Y = (h16*)(ws + WS_Y); h16* H = (h16*)(ws + WS_H);
    const int lo = a.ph_lo, hi = a.ph_hi;
#ifndef MK_MASK
#define MK_MASK 0x1ff
#endif
#define IN(k) (lo <= (k) && (k) < hi)
#define INL(x) (((MK_MASK >> (x)) & 1) && IN(pb + (x)))
    volatile LAS unsigned* bst = (volatile LAS unsigned*)(lds + LDS_BYTES - 64);
    if (tid == 0) { bst[0] = 0u; bst[1] = 0u; }
    __syncthreads();
    if (a.ph_lo < 0) grid.sync();
    XcdBarrier xbar = xcd_barrier_post((unsigned*)(ws + WS_BAR), bst);
#define SEAM(k) do { if (IN(k) && IN((k) + 1)) { for (int rs_ = 0; rs_ < MK_REP_SYNC; ++rs_) xcd_barrier(xbar); } } while (0)

    if (((MK_MASK >> 7) & 1) && IN(0)) {
        ZQ();
        for (int rep_ = 0; rep_ < MK_REP_ADA; ++rep_) for (int t = gw; t < 96 * 8; t += NGW) p0_ada_task(c_in, cctx_in, w_ada, b_ada, MOD, t, lane, rep_ == 0 ? 1.f : 0.f);
        LAS float* scr = (LAS float*)(lds + wave * 16384);
        for (int rep_ = 0; rep_ < MK_REP_TR; ++rep_) for (int it = gw; it < W_ITEMS; it += NGW)
            weight_item(it, w_in, w_out, w_gate, w_up, w_down, ws + WS_W, scr, lane);
        for (int i = blk * 512 + tid; i < SEQ * 48; i += G * 512) {
            if (i < SEQ * 32) { const int t = i >> 5, f = i & 31; const float pos = (f < 16) ? (float)(t >> 6) : (float)(t & 63);
                const float inv = exp2f(-(float)(f & 15) * (13.287712379549449f / 16.f)); const float ang = pos * inv; ropeA[i] = make_float2(__cosf(ang), __sinf(ang)); }
            else { const int i2 = i - SEQ * 32; const int t = i2 >> 4, f = i2 & 15; const float pos = (f < 8) ? (float)(t >> 6) : (float)(t & 63);
                const float inv = exp2f(-(float)(f & 7) * (13.287712379549449f / 8.f)); const float ang = pos * inv; ropeC[i2] = make_float2(__cosf(ang), __sinf(ang)); }
        }
    }
    SEAM(0);
    float* SSQ = (float*)(ws + WS_SSQ);
    for (int rep_ = 0; rep_ < MK_REP_N1; ++rep_) if (((MK_MASK >> 7) & 1) && IN(1)) {
        ZQ();
        prep_rows(gw, NGW, lane, x_in, ctx_in, XN, norm1_g, MOD, 1 * DM, SSQ, MT);
        for (int t = blk; t < (SHWW / 64); t += G) {
            const int l = t >> 7, p0 = (t & 127) * 64;
            unsigned char* wb = ws + WS_W + (size_t)l * WS_WSTRIDE;
            const h16* wrow = (p0 < INW) ? (const h16*)wb + (size_t)p0 * DM : (const h16*)(wb + WGU_OFF) + (size_t)(p0 - INW) * DM;
            shw_block_task(lds, wrow, MOD + (size_t)l * 9 * MODW, (p0 < INW) ? 0 : 3 * DM, (float*)(wb + SHW_OFF) + p0);
        }
    }
    SEAM(1);

    for (int l = 0; l < 2; ++l) {
        const int pb = 2 + 6 * l;
        const bool ctx_needed = (l == 0);
        const float* modl = MOD + (size_t)l * 9 * MODW;
        unsigned char* wb = ws + WS_W + (size_t)l * WS_WSTRIDE;
#define srcX0 ((l == 0) ? x_in : (const float*)XO)
#define srcC0 ((l == 0) ? ctx_in : (const float*)CR)
        const int Mff = ctx_needed ? MT : MX;
        for (int rep_ = 0; rep_ < MK_REP_IN; ++rep_) if (INL(0)) {
            ZQ();
            pg8::Gemm g{(const pg8::bf16_t*)XN, (const pg8::bf16_t*)wb, MT, INW, DM};
            PrefOrder S; S.init(MT, INW, G, blk); S.ssq = SSQ + (size_t)(2 * l) * MT; S.shw = (const float*)(wb + SHW_OFF); S.ldsb = lds; S.na = 0;
            EpiInProj E{PRJ, ropeA, ropeC, lds, 0};
            pg8::gemm_phase<EpiInProj, PrefOrder, true, true>(lds, g, S, E);
        }
        SEAM(pb + 0);
        for (int rep_ = 0; rep_ < MK_REP_MIX; ++rep_) if (INL(1)) {
            ZQ();
            const float lam_init = 0.8f - 0.6f * expf(-0.3f * (float)l);
            float d1 = 0.f, d2 = 0.f;
            for (int i = 0; i < 32; ++i) { d1 += lq1[l * 32 + i] * lk1[l * 32 + i]; d2 += lq2[l * 32 + i] * lk2[l * 32 + i]; }
            const float lam = expf(d1) - expf(d2) + lam_init;
            const float* sinkp = attn_sink + l * 4; const float* rpb = na_rpb + l * 4 * 465; const float* subg = subln_g + l * 64;
#ifndef MK_CTX
#define MK_CTX 15
#endif
#ifndef MK_MIX
#define MK_MIX 0x1f
#endif
            const int nau = ctx_needed ? 288 : 256, ncu = ctx_needed ? 576 : 512;
            if (MK_MIX & 1) for (int w = blk; w < nau; w += G) { const bool cq = w >= 256; const int u = w & 255;
                attn_unit<1>(lds, PRJ, Y, cq ? (u >> 2) : (u >> 5), cq ? (u & 3) : ((u >> 3) & 3), cq ? 0 : (u & 7), cq, sinkp, rpb, lam, lam_init, subg); }
            asm volatile("" ::: "memory");
            if (MK_MIX & 2) for (int w = (blk + 32) % G; w < nau; w += G) { const bool cq = w >= 256; const int u = w & 255;
                attn_unit<0>(lds, PRJ, Y, cq ? (u >> 2) : (u >> 5), cq ? (u & 3) : ((u >> 4) & 1), cq ? 0 : (u & 15), cq, sinkp, rpb, lam, lam_init, subg); }
            asm volatile("" ::: "memory");
            if (MK_MIX & 4) for (int w = (blk + 64) % G; w < nau; w += G) { const bool cq = w >= 256; const int u = w & 255;
                attn_unit<2>(lds, PRJ, Y, cq ? (u >> 2) : (u >> 5), cq ? (u & 3) : ((u >> 3) & 3), cq ? 0 : (u & 7), cq, sinkp, rpb, lam, lam_init, subg); }
            asm volatile("" ::: "memory");
            if (MK_MIX & 8) for (int w = (blk + 96) % G; w < ncu; w += G) { const bool cq = w >= 512; const int v = w - 512;
                conv_unit(lds, PRJ, Y, cq ? MX + (v >> 3) * CTXL : (w >> 6) * SEQ, cq ? CTXL : SEQ, cq ? (v & 7) * 32 : (w & 63) * 32, conv_w + l * 31 * 256, conv_b + l * 256, conv_ln_g + l * 256, conv_ln_b + l * 256); }
        }
        SEAM(pb + 1);
        for (int rep_ = 0; rep_ < MK_REP_OUT; ++rep_) if (INL(2)) {
            ZQ();
            pg8::Gemm g{(const pg8::bf16_t*)Y, (const pg8::bf16_t*)(wb + WO_OFF), Mff, DM, DM}; pg8::StaticOrder S; S.init(Mff, DM, G, blk);
            EpiResid E{srcX0, srcC0, XO, CR, modl + 2 * DM, XN, norm2_g + l * DM, modl + 4 * DM, SSQ + (size_t)(2 * l + 1) * MT, (rep_ == MK_REP_OUT - 1) ? 1 : 0, (rep_ == MK_REP_OUT - 1) ? 1.f : 0.f};
            pg8::gemm_phase<EpiResid, pg8::StaticOrder, true, true>(lds, g, S, E);
            if (l == 0 && rep_ == MK_REP_OUT - 1) {
                const int nwg = (Mff / 256) * (DM / 256), rounds = (nwg + G - 1) / G, rem = nwg - (rounds - 1) * G;
                const int first = (rem < G) ? rem : 0, nidle = G - first;
                if (blk >= first) {
                    LAS float* scr = (LAS float*)(lds + wave * 16384);
                    for (int it = (blk - first) * 8 + wave; it < W_ITEMS; it += nidle * 8)
                        weight_item(it, w_in + (size_t)DM * INW, w_out + (size_t)DM * DM, w_gate + (size_t)DM * FF, w_up + (size_t)DM * FF, w_down + (size_t)FF * DM, ws + WS_W + WS_WSTRIDE, scr, lane);
                    for (int t = 96 * 8 + (blk - first) * 8 + wave; t < 2 * 96 * 8; t += nidle * 8) p0_ada_task(c_in, cctx_in, w_ada, b_ada, MOD, t, lane, 1.f);
                }
            }
        }
        SEAM(pb + 2);
        for (int rep_ = 0; rep_ < MK_REP_GU; ++rep_) if (INL(3)) {
            ZQ();
            pg8::Gemm g{(const pg8::bf16_t*)XN, (const pg8::bf16_t*)(wb + WGU_OFF), Mff, 2 * FF, DM};
            PrefOrder S; S.init(Mff, 2 * FF, G, blk); S.ssq = SSQ + (size_t)(2 * l + 1) * MT; S.shw = (const float*)(wb + SHW_OFF) + INW; S.ldsb = lds; S.na = 0;
#ifdef MK_GU_VARIANT
            if (rep_ == 0) { EpiSwigluT<true> E{H, lds, 0}; pg8::gemm_phase<EpiSwigluT<true>, PrefOrder, true, true>(lds, g, S, E); }
            else
#endif
            { EpiSwigluT<false> E{H, lds, 0}; pg8::gemm_phase<EpiSwigluT<false>, PrefOrder, true, true>(lds, g, S, E); }
        }
        SEAM(pb + 3);
        for (int rep_ = 0; rep_ < MK_REP_DN; ++rep_) if (INL(4)) {
            ZQ();
            {
                pg8::Gemm g{(const pg8::bf16_t*)H, (const pg8::bf16_t*)(wb + WD_OFF), MX, DM, FF}; pg8::StaticOrder S; S.init(MX, DM, G, blk);
                EpiResid E{XO, CR, XO, CR, modl + 5 * DM, XN, norm1_g + (l + 1 < 2 ? l + 1 : 1) * DM, MOD + (size_t)(l + 1 < 2 ? l + 1 : 1) * 9 * MODW + 1 * DM, SSQ + (size_t)(2 * (l + 1 < 2 ? l + 1 : 1)) * MT, (l == 0 && rep_ == MK_REP_DN - 1) ? 1 : 0, (rep_ == MK_REP_DN - 1) ? 1.f : 0.f};
                pg8::gemm_phase<EpiResid, pg8::StaticOrder, true, true>(lds, g, S, E);
            }
            if (ctx_needed) {
                pg8::Gemm g{(const pg8::bf16_t*)H, (const pg8::bf16_t*)(wb + WD_OFF), MT, DM, FF}; CtxSplitOrder S{G, blk};
                EpiPartial E{(h16*)(ws + WS_PART)};
                pg8::gemm_phase<EpiPartial, CtxSplitOrder, true, true>(lds, g, S, E);
            }
        }
        SEAM(pb + 4);
        if (ctx_needed) {
            if (INL(4) && IN(pb + 5)) { ZQ(); ctx_fix_rows(gw, NGW, lane, CR, (const h16*)(ws + WS_PART), modl + 5 * DM + 8 * MODW, XN, norm1_g + DM, MOD + (size_t)9 * MODW + 1 * DM + 8 * MODW, SSQ + (size_t)2 * MT);
                for (int t = blk; t < (SHWW / 64); t += G) {
                    const int p0 = t * 64;
                    unsigned char* wb1 = ws + WS_W + WS_WSTRIDE;
                    const h16* wrow = (p0 < INW) ? (const h16*)wb1 + (size_t)p0 * DM : (const h16*)(wb1 + WGU_OFF) + (size_t)(p0 - INW) * DM;
                    shw_block_task(lds, wrow, MOD + (size_t)9 * MODW, (p0 < INW) ? 0 : 3 * DM, (float*)(wb1 + SHW_OFF) + p0);
                } }
            SEAM(pb + 5);
        }
    }
    if (((MK_MASK >> 8) & 1) && IN(14)) { ZQ(); final_norm_rows(gw, NGW, lane, XO, final_g); }
#undef IN
#undef SEAM
#undef srcX0
#undef srcC0
#undef x_in
#undef c_in
#undef ctx_in
#undef cctx_in
#undef norm1_g
#undef norm2_g
#undef w_ada
#undef b_ada
#undef w_in
#undef w_out
#undef attn_sink
#undef conv_w
#undef conv_b
#undef conv_ln_g
#undef conv_ln_b
#undef lq1
#undef lk1
#undef lq2
#undef lk2
#undef subln_g
#undef na_rpb
#undef w_gate
#undef w_up
#undef w_down
#undef final_g
}

#ifndef MK_PER_PHASE
#define MK_PER_PHASE 0
#endif
extern "C" void kernel_launch(void* const* d_in, const int* in_sizes, int n_in, void* d_out, int out_size, void* d_ws, size_t ws_size, hipStream_t stream) {
    static int grid = 0;
    if (grid == 0) {
        int dev = 0, cus = 0, per_cu = 0;
        (void)hipGetDevice(&dev);
        (void)hipDeviceGetAttribute(&cus, hipDeviceAttributeMultiprocessorCount, dev);
        if (hipFuncSetAttribute((const void*)mega_fwd, hipFuncAttributeMaxDynamicSharedMemorySize, LDS_BYTES) != hipSuccess) fprintf(stderr, "kernel_launch: hipFuncSetAttribute failed\n");
        if (hipOccupancyMaxActiveBlocksPerMultiprocessor(&per_cu, (const void*)mega_fwd, 512, LDS_BYTES) != hipSuccess || per_cu < 1) { fprintf(stderr, "kernel_launch: occupancy query gave %d\n", per_cu); per_cu = 1; }
        (void)hipGetLastError();
        grid = cus * per_cu;
        if (n_in != 25 || ws_size < WS_END) fprintf(stderr, "kernel_launch: unexpected n_in %d / ws %zu\n", n_in, ws_size);
    }
    (void)hipMemsetAsync((char*)d_ws, 0, 1u << 20, stream);
    Args a{};
    for (int i = 0; i < 25; ++i) a.in[i] = (const float*)d_in[i];
    a.out = (float*)d_out; a.ws = (unsigned char*)d_ws;
#if MK_PER_PHASE
    for (int p = 0; p < N_PHASES; ++p) {
        a.ph_lo = p; a.ph_hi = p + 1;
        void* args[] = {&a};
        hipError_t e = hipLaunchCooperativeKernel((const void*)mega_fwd, dim3(grid), dim3(512), args, LDS_BYTES, stream);
        if (e != hipSuccess) { fprintf(stderr, "kernel_launch: launch of phase %d failed: %s (grid %d)\n", p, hipGetErrorString(e), grid); break; }
    }
#else
    a.ph_lo = 0; a.ph_hi = N_PHASES;
    void* args[] = {&a};
    hipError_t e = hipLaunchCooperativeKernel((const void*)mega_fwd, dim3(grid), dim3(512), args, LDS_BYTES, stream);
    if (e != hipSuccess) fprintf(stderr, "kernel_launch: cooperative launch failed: %s (grid %d)\n", hipGetErrorString(e), grid);
#endif
}
```

```cpp
#include <hip/hip_runtime.h>
#include <hip/hip_cooperative_groups.h>
#include <cstdio>
#include <cstdint>
namespace cg = cooperative_groups;
namespace pg8 {
#define PG8_LAS __attribute__((address_space(3)))
typedef unsigned short bf16_t;
typedef _Float16 bf16x8 __attribute__((ext_vector_type(8)));
typedef float f32x4 __attribute__((ext_vector_type(4)));
typedef unsigned u32x4 __attribute__((ext_vector_type(4)));
constexpr int BM = 256, BK = 64, HALF = 128, HTB = HALF * BK * 2  , STAGE_BYTES = 8 * HTB, NXCD = 8, WGM = 8;

__host__ __device__ __forceinline__ int lds_byte(int r, int c) { const int st = (r >> 4) * 2 + (c >> 5), rr = r & 15, cc = c & 31, ob = rr * 64 + cc * 2; return st * 1024 + (ob ^ (((ob >> 9) & 1) << 5)); }
__host__ __device__ __forceinline__ void stage_rc(int b, int& R, int& C) { const int st = b / 1024, sb = b % 1024, swz = sb ^ (((sb >> 9) & 1) << 5); R = (st >> 1) * 16 + swz / 64; C = (st & 1) * 32 + (swz % 64) / 2; }
__host__ __device__ __forceinline__ int perm32(int rho) { const int n = rho >> 4, i = rho & 15; return 8 * (i >> 2) + 4 * n + (i & 3); }

struct Unit { int pm, pn, ko, nt; };
struct Gemm { const bf16_t* A; const bf16_t* Bt; int M, N, K; };

struct StaticOrder {
    int nM, nN, nwg, G, c;
    __host__ __device__ void init(int M, int N, int G_, int c_) { nM = M / BM; nN = N / BM; nwg = nM * nN; G = G_; c = c_; }
    __host__ __device__ bool next(int i, Unit& u) const {
        const long L = (long)i * G + c; if (L >= nwg) return false;
        int wgid = (int)L; { const int q = nwg / NXCD, r = nwg % NXCD, xcd = wgid % NXCD, off = wgid / NXCD; wgid = (xcd < r ? xcd * (q + 1) : r * (q + 1) + (xcd - r) * q) + off; }
        const int nig = WGM * nN, gid = wgid / nig, fm = gid * WGM, gsz = (nM - fm) < WGM ? (nM - fm) : WGM;
        u.pm = fm + ((wgid % nig) % gsz); u.pn = (wgid % nig) / gsz; u.ko = 0; u.nt = 0; return true;
    }
    __device__ __forceinline__ void a_ready(const Unit&) const {}
    __device__ __forceinline__ void done(const Unit&) const {}
};

template <class Epi, class Sched, bool ALIGN_EPI = false, bool SP2 = false>
__device__ __forceinline__ void gemm_phase(PG8_LAS unsigned char* lds, const Gemm g, const Sched& S, const Epi& E) {
    int tid_l = threadIdx.x; asm volatile("" : "+v"(tid_l));
    const int tid = tid_l, wid = __builtin_amdgcn_readfirstlane(tid >> 6), lane = tid & 63, wr = wid >> 2, wc = wid & 3, fr = lane & 15, fq = lane >> 4;
    const int K = g.K; int nt = K / BK;
    unsigned voffA[2], voffB[2];
#pragma unroll
    for (int i = 0; i < 2; ++i) { int R, C; stage_rc(tid * 16 + i * 8192, R, C); const int Rb = Epi::PERM ? ((R & ~31) + perm32(R & 31)) : R;
        voffA[i] = (unsigned)(R * K + C) * 2u; voffB[i] = (unsigned)(Rb * K + C) * 2u; }
    const size_t kstep = (size_t)(BK * 2);
    const size_t hstep = (size_t)HALF * K * 2;
    const size_t tstep = 2 * hstep;
    const unsigned ldsw = (unsigned)wid * 1024u;
    const int aoff = lds_byte(wr * 64 + fr, fq * 8), boff = lds_byte(wc * 32 + fr, fq * 8);
#define PG8_SA(b, h) (((b) * 2 + (h)) * HTB)
#define PG8_SB(b, h) ((4 + (b) * 2 + (h)) * HTB)
#define PG8_STAGE(bufoff, gbase, voff) do { _Pragma("unroll") for (int _i = 0; _i < 2; ++_i) \
        __builtin_amdgcn_global_load_lds((const unsigned*)((const char*)(gbase) + (voff)[_i]), (PG8_LAS unsigned*)(lds + (bufoff) + ldsw + _i * 8192), 16, 0, 0); } while (0)
#define PG8_LDA(dst, b, h) do { _Pragma("unroll") for (int m = 0; m < 4; ++m) _Pragma("unroll") for (int k = 0; k < 2; ++k) dst[m][k] = *(const PG8_LAS bf16x8*)(lds + PG8_SA(b, h) + aoff + m * 2048 + k * 1024); } while (0)
#define PG8_LDB(dst, b, h) do { _Pragma("unroll") for (int n = 0; n < 2; ++n) _Pragma("unroll") for (int k = 0; k < 2; ++k) dst[n][k] = *(const PG8_LAS bf16x8*)(lds + PG8_SB(b, h) + boff + n * 2048 + k * 1024); } while (0)
#define PG8_MMA(ai, bj, At, Bt) do { __builtin_amdgcn_s_setprio(1); _Pragma("unroll") for (int m = 0; m < 4; ++m) _Pragma("unroll") for (int n = 0; n < 2; ++n) _Pragma("unroll") for (int k = 0; k < 2; ++k) \
        acc[ai][bj][m][n] = __builtin_amdgcn_mfma_f32_16x16x32_f16(Bt[n][k], At[m][k], acc[ai][bj][m][n], 0, 0, 0); __builtin_amdgcn_s_setprio(0); } while (0)
#define PG8_WAIT_V(n) asm volatile("s_waitcnt vmcnt(" #n ")" ::: "memory")
#define PG8_WAIT_L(n) asm volatile("s_waitcnt lgkmcnt(" #n ")" ::: "memory")
#define PG8_BAR __builtin_amdgcn_s_barrier()
#define PG8_SCHED __builtin_amdgcn_sched_barrier(0)
    Unit cur, nxt; int ui = 0;
    if (!S.next(0, cur)) return;
    if (cur.nt) nt = cur.nt;
    f32x4 acc[2][2][4][2];
#pragma unroll
    for (int a = 0; a < 2; ++a)
#pragma unroll
        for (int b = 0; b < 2; ++b)
#pragma unroll
            for (int m = 0; m < 4; ++m)
#pragma unroll
                for (int n = 0; n < 2; ++n) acc[a][b][m][n] = (f32x4){0.f, 0.f, 0.f, 0.f};
    bf16x8 At[4][2], B0[2][2], B1[2][2];
    const char* cA = (const char*)g.A + (size_t)cur.pm * tstep + cur.ko; const char* cB = (const char*)g.Bt + (size_t)cur.pn * tstep + cur.ko;
    S.a_ready(cur);
    if constexpr (SP2) {
        PG8_STAGE(PG8_SB(0, 0), cB, voffB); PG8_STAGE(PG8_SB(0, 1), cB + hstep, voffB); PG8_STAGE(PG8_SA(0, 0), cA, voffA); PG8_STAGE(PG8_SA(0, 1), cA + hstep, voffA);
        if (wr == 1) PG8_BAR;
        PG8_WAIT_V(2); PG8_BAR;
        PG8_STAGE(PG8_SB(1, 0), cB + kstep, voffB); PG8_STAGE(PG8_SA(1, 0), cA + kstep, voffA); PG8_STAGE(PG8_SB(1, 1), cB + hstep + kstep, voffB);
        PG8_WAIT_V(6); PG8_BAR;
    } else {
        PG8_STAGE(PG8_SB(0, 0), cB, voffB); PG8_STAGE(PG8_SA(0, 0), cA, voffA); PG8_STAGE(PG8_SB(0, 1), cB + hstep, voffB); PG8_STAGE(PG8_SA(0, 1), cA + hstep, voffA);
        if (wr == 1) PG8_BAR;
        PG8_WAIT_V(4); PG8_BAR;
        PG8_STAGE(PG8_SB(1, 0), cB + kstep, voffB); PG8_STAGE(PG8_SA(1, 0), cA + kstep, voffA); PG8_STAGE(PG8_SB(1, 1), cB + hstep + kstep, voffB);
        PG8_WAIT_V(6); PG8_BAR;
    }
    for (;;) {
        const bool has_next = S.next(ui + 1, nxt);
        const char* nA = has_next ? (const char*)g.A + (size_t)nxt.pm * tstep + nxt.ko : cA; const char* nB = has_next ? (const char*)g.Bt + (size_t)nxt.pn * tstep + nxt.ko : cB;
        for (int t = 0; t < nt; t += 2) {
            const bool last = (t == nt - 2);
            const char* a1 = cA + (size_t)(t + 1) * kstep;
            const char* a2 = last ? nA : cA + (size_t)(t + 2) * kstep; const char* b2 = last ? nB : cB + (size_t)(t + 2) * kstep;
            const char* a3 = a2 + kstep; const char* b3 = b2 + kstep;
            if (last && has_next) S.a_ready(nxt);
            if constexpr (SP2) {
            PG8_LDB(B0, 0, 0); PG8_LDB(B1, 0, 1); PG8_SCHED; PG8_LDA(At, 0, 0); PG8_STAGE(PG8_SA(1, 1), a1 + hstep, voffA);
            PG8_WAIT_V(8); PG8_WAIT_L(0); PG8_BAR; PG8_MMA(0, 0, At, B0); PG8_MMA(0, 1, At, B1); PG8_BAR; PG8_SCHED;
            PG8_LDA(At, 0, 1); PG8_STAGE(PG8_SB(0, 0), b2, voffB); PG8_STAGE(PG8_SB(0, 1), b2 + hstep, voffB); PG8_STAGE(PG8_SA(0, 0), a2, voffA);
            PG8_WAIT_V(8); PG8_WAIT_L(0); PG8_BAR; PG8_MMA(1, 0, At, B0); PG8_MMA(1, 1, At, B1); PG8_BAR; PG8_SCHED;
            PG8_LDB(B0, 1, 0); PG8_LDB(B1, 1, 1); PG8_SCHED; PG8_LDA(At, 1, 0); PG8_STAGE(PG8_SA(0, 1), a2 + hstep, voffA);
            PG8_WAIT_V(8); PG8_WAIT_L(0); PG8_BAR; PG8_MMA(0, 0, At, B0); PG8_MMA(0, 1, At, B1); PG8_BAR; PG8_SCHED;
            PG8_LDA(At, 1, 1); PG8_STAGE(PG8_SB(1, 0), b3, voffB); PG8_STAGE(PG8_SB(1, 1), b3 + hstep, voffB); PG8_STAGE(PG8_SA(1, 0), a3, voffA);
            PG8_WAIT_V(8); PG8_WAIT_L(0); PG8_BAR; PG8_MMA(1, 0, At, B0); PG8_MMA(1, 1, At, B1); PG8_BAR; PG8_SCHED;
            } else {
            PG8_LDB(B0, 0, 0); PG8_SCHED; PG8_LDA(At, 0, 0); PG8_STAGE(PG8_SA(1, 1), a1 + hstep, voffA);
            PG8_WAIT_L(8); PG8_BAR; PG8_WAIT_L(0); PG8_MMA(0, 0, At, B0); PG8_BAR; PG8_SCHED;
            PG8_LDB(B1, 0, 1); PG8_STAGE(PG8_SB(0, 0), b2, voffB);
            PG8_BAR; PG8_WAIT_L(0); PG8_MMA(0, 1, At, B1); PG8_BAR;
            PG8_LDA(At, 0, 1); PG8_STAGE(PG8_SA(0, 0), a2, voffA);
            PG8_BAR; PG8_WAIT_L(0); PG8_MMA(1, 0, At, B0); PG8_BAR; PG8_SCHED;
            PG8_STAGE(PG8_SB(0, 1), b2 + hstep, voffB);
            PG8_WAIT_V(6); PG8_BAR; PG8_MMA(1, 1, At, B1); PG8_BAR;
            PG8_LDB(B0, 1, 0); PG8_SCHED; PG8_LDA(At, 1, 0); PG8_STAGE(PG8_SA(0, 1), a2 + hstep, voffA);
            PG8_WAIT_L(8); PG8_BAR; PG8_WAIT_L(0); PG8_MMA(0, 0, At, B0); PG8_BAR; PG8_SCHED;
            PG8_LDB(B1, 1, 1); PG8_STAGE(PG8_SB(1, 0), b3, voffB);
            PG8_BAR; PG8_WAIT_L(0); PG8_MMA(0, 1, At, B1); PG8_BAR;
            PG8_LDA(At, 1, 1); PG8_STAGE(PG8_SA(1, 0), a3, voffA);
            PG8_BAR; PG8_WAIT_L(0); PG8_MMA(1, 0, At, B0); PG8_BAR; PG8_SCHED;
            PG8_STAGE(PG8_SB(1, 1), b3 + hstep, voffB);
            PG8_WAIT_V(6); PG8_BAR; PG8_MMA(1, 1, At, B1); PG8_BAR;
            }
        }
        if constexpr (ALIGN_EPI) { if (wr == 0) PG8_BAR; }
        if constexpr (!Epi::AFTER_DRAIN) { E(acc, cur, wr, wc, fr, fq); S.done(cur); }
        if (!has_next) break;
#pragma unroll
        for (int a = 0; a < 2; ++a)
#pragma unroll
            for (int b = 0; b < 2; ++b)
#pragma unroll
                for (int m = 0; m < 4; ++m)
#pragma unroll
                    for (int n = 0; n < 2; ++n) acc[a][b][m][n] = (f32x4){0.f, 0.f, 0.f, 0.f};
        cur = nxt; cA = nA; cB = nB; ++ui; nt = cur.nt ? cur.nt : K / BK;
        if constexpr (ALIGN_EPI) { if (wr == 1) PG8_BAR; }
    }
    PG8_WAIT_V(0);
    if constexpr (!ALIGN_EPI) { if (wr == 0) PG8_BAR; }
    PG8_BAR;
    if constexpr (Epi::AFTER_DRAIN) { E.fused(acc, cur, wr, wc, fr, fq, lds, wid, lane); S.done(cur); }
#undef PG8_SA
#undef PG8_SB
#undef PG8_STAGE
#undef PG8_LDA
#undef PG8_LDB
#undef PG8_MMA
#undef PG8_WAIT_V
#undef PG8_WAIT_L
#undef PG8_BAR
#undef PG8_SCHED
}
}

#ifndef MK_REP_GU
#define MK_REP_GU 1
#endif
#ifndef MK_REP_IN
#define MK_REP_IN 1
#endif
#ifndef MK_REP_SYNC
#define MK_REP_SYNC 1
#endif
#ifndef MK_REP_N1
#define MK_REP_N1 1
#endif
#ifndef MK_REP_TR
#define MK_REP_TR 1
#endif
#ifndef MK_REP_ADA
#define MK_REP_ADA 1
#endif
#ifndef MK_REP_OUT
#define MK_REP_OUT 1
#endif
#ifndef MK_REP_DN
#define MK_REP_DN 1
#endif
#ifndef MK_REP_MIX
#define MK_REP_MIX 1
#endif
constexpr int DM = 1024, NB = 8, SEQ = 2048, CTXL = 256;
constexpr int MX = NB * SEQ;
constexpr int MC = NB * CTXL;
constexpr int MT = MX + MC;
constexpr int INW = 2560, FF = 2816, MODW = 6 * DM;
constexpr float EPS = 1e-6f;
constexpr float LOG2E = 1.4426950408889634f;

#define LAS __attribute__((address_space(3)))
typedef _Float16 h16;
typedef _Float16 h8 __attribute__((ext_vector_type(8)));
typedef _Float16 h4 __attribute__((ext_vector_type(4)));
typedef _Float16 h2 __attribute__((ext_vector_type(2)));
typedef float f32x4 __attribute__((ext_vector_type(4)));
typedef float f32x2 __attribute__((ext_vector_type(2)));
typedef float f32x16 __attribute__((ext_vector_type(16)));
typedef unsigned u32x4 __attribute__((ext_vector_type(4)));
typedef unsigned u32x2 __attribute__((ext_vector_type(2)));

constexpr size_t MiB = 1u << 20;
constexpr size_t WS_MOD = 0;
constexpr size_t MOD_BYTES = (size_t)2 * 9 * MODW * 4;
constexpr size_t WS_ROPEA = 1 * MiB;
constexpr size_t WS_ROPEC = 1 * MiB + 512 * 1024;
constexpr size_t WS_W = 2 * MiB, WS_WSTRIDE = 24 * MiB;
constexpr size_t WO_OFF = 5 * MiB, WGU_OFF = 7 * MiB, WD_OFF = 18 * MiB;
constexpr size_t WS_XN = 50 * MiB;
constexpr size_t WS_CR = 86 * MiB;
constexpr size_t WS_PRJ = 94 * MiB;
constexpr size_t WS_Y = 184 * MiB;
constexpr size_t WS_H = 94 * MiB;
constexpr size_t WS_END = 252 * MiB;
constexpr size_t WS_PART = 220 * MiB;
constexpr size_t WS_SSQ = 448 * 1024;
constexpr size_t SHW_OFF = 23 * MiB + 512 * 1024;
constexpr int SHWW = 8192;

constexpr int LDS_BYTES = 147456;

__device__ __forceinline__ unsigned pkh2(float lo, float hi) { h2 v = {(h16)lo, (h16)hi}; return __builtin_bit_cast(unsigned, v); }
__device__ __forceinline__ float wave_sum(float v) {
#pragma unroll
    for (int o = 1; o < 64; o <<= 1) v += __shfl_xor(v, o);
    return v;
}
__device__ __forceinline__ float ex2(float x) { return __builtin_amdgcn_exp2f(x); }
__device__ __forceinline__ float silu_f(float g) { return g * __builtin_amdgcn_rcpf(1.f + ex2(-g * LOG2E)); }

#ifndef MK_WT
#define MK_WT 0
#endif
__device__ __forceinline__ void store16_wt(void* p, u32x4 v) {
#if MK_WT
    asm volatile("global_store_dwordx4 %0, %1, off sc1\n\ts_nop 1" :: "v"(p), "v"(v) : "memory");
#else
    *(u32x4*)p = v;
#endif
}
__device__ __forceinline__ f32x4 rot4(const f32x4 v, const f32x4 cs) { f32x4 o; o[0] = v[0] * cs[0] - v[1] * cs[1]; o[1] = v[0] * cs[1] + v[1] * cs[0]; o[2] = v[2] * cs[2] - v[3] * cs[3]; o[3] = v[2] * cs[3] + v[3] * cs[2]; return o; }

constexpr int PF_OFF = 131072, PF_SLOT = 2048;
struct PrefOrder : pg8::StaticOrder {
    const float* ssq; const float* shw; LAS unsigned char* ldsb; mutable int na;
    __device__ __forceinline__ void a_ready(const pg8::Unit& u) const {
        const int w = __builtin_amdgcn_readfirstlane(threadIdx.x >> 6), lane = threadIdx.x & 63;
        const int bidx = (u.pm < 64) ? (u.pm >> 3) : 8;
        const float* gp = (w < 4) ? ssq + u.pm * 256 + w * 64 + lane : shw + bidx * SHWW + u.pn * 256 + (w - 4) * 64 + lane;
        __builtin_amdgcn_global_load_lds((const unsigned*)gp, (LAS unsigned*)(ldsb + PF_OFF + (na & 1) * PF_SLOT + w * 256), 4, 0, 0);
        na += 1;
    }
};

struct EpiInProj {
    static constexpr bool PERM = true, AFTER_DRAIN = false;
    h16* PRJ; const float2* ropeA; const float2* ropeC; LAS unsigned char* ldsb; mutable int ne;
    __device__ __forceinline__ void operator()(const f32x4 (&acc)[2][2][4][2], const pg8::Unit& u, int wr, int wc, int fr, int fq) const {
        const LAS float* slot = (const LAS float*)(ldsb + PF_OFF + (ne & 1) * PF_SLOT); ne += 1;
#pragma unroll
        for (int bj = 0; bj < 2; ++bj) {
            const int hb = 2 * u.pn + bj;
            const int col0 = hb * 128 + wc * 32 + 8 * fq;
            const f32x4 sw0 = *(const LAS f32x4*)(slot + 256 + bj * 128 + wc * 32 + 8 * fq), sw1 = *(const LAS f32x4*)(slot + 256 + bj * 128 + wc * 32 + 8 * fq + 4);
            const int ropeMode = (hb <= 2) ? 1 : ((hb >= 8 && hb <= 11) ? 2 : 0);
            const float sc = (hb <= 1 || hb == 14 || hb == 15) ? 0.125f * LOG2E : ((hb == 8 || hb == 9) ? 0.17677669529663687f * LOG2E : 1.f);
#pragma unroll
            for (int ai = 0; ai < 2; ++ai)
#pragma unroll
                for (int m = 0; m < 4; ++m) {
                    const int row = u.pm * 256 + ai * 128 + wr * 64 + m * 16 + fr;
                    const float rs = __builtin_amdgcn_rsqf(slot[ai * 128 + wr * 64 + m * 16 + fr] * (1.f / DM) + EPS);
                    f32x4 v0 = acc[ai][bj][m][0] * rs + sw0, v1 = acc[ai][bj][m][1] * rs + sw1;
                    if (ropeMode != 0 && row < MX) {
                        const int t = row & (SEQ - 1);
                        const float2* tab = (ropeMode == 1) ? ropeA + t * 32 + (((wc * 32 + 8 * fq) & 63) >> 1) : ropeC + t * 16 + 4 * fq;
                        const f32x4 c01 = *(const f32x4*)tab, c23 = *(const f32x4*)(tab + 2);
                        v0 = rot4(v0, c01); v1 = rot4(v1, c23);
                    }
                    v0 = v0 * sc; v1 = v1 * sc;
                    u32x4 w; w.x = pkh2(v0[0], v0[1]); w.y = pkh2(v0[2], v0[3]); w.z = pkh2(v1[0], v1[1]); w.w = pkh2(v1[2], v1[3]);
                    store16_wt(PRJ + (size_t)row * INW + col0, w);
                    if (m & 1) asm volatile("" ::: "memory");
                }
        }
    }
};

struct EpiResid {
    static constexpr bool PERM = false, AFTER_DRAIN = false;
    const float* srcX; const float* srcC; float* dstX; float* dstC; const float* gate;
    h16* XN; const float* ng; const float* scl; float* ssq; int emit; float gsc;
    __device__ __forceinline__ void operator()(const f32x4 (&acc)[2][2][4][2], const pg8::Unit& u, int wr, int wc, int fr, int fq) const {
        const int bidx = (u.pm < 64) ? (u.pm >> 3) : 8;
        const int colb = u.pn * 256 + wc * 32 + 4 * fq;
        f32x4 g4[2][2], gm[2][2];
#pragma unroll
        for (int bj = 0; bj < 2; ++bj)
#pragma unroll
            for (int n = 0; n < 2; ++n) { const int col = colb + bj * 128 + n * 16; g4[bj][n] = *(const f32x4*)(gate + bidx * MODW + col) * gsc;
                gm[bj][n] = emit ? *(const f32x4*)(ng + col) * (*(const f32x4*)(scl + bidx * MODW + col) + 1.f) : (f32x4){0.f, 0.f, 0.f, 0.f}; }
#ifndef MK_RB
#define MK_RB 2
#endif
#pragma unroll
        for (int t = 0; t < 8 / MK_RB; ++t) {
            f32x4 xb[MK_RB][2][2];
#pragma unroll
            for (int k = 0; k < MK_RB; ++k) {
                const int rg = t * MK_RB + k, row = u.pm * 256 + (rg >> 2) * 128 + wr * 64 + (rg & 3) * 16 + fr;
                const float* sp = (row < MX) ? srcX + (size_t)row * DM : srcC + (size_t)(row - MX) * DM;
#pragma unroll
                for (int bj = 0; bj < 2; ++bj)
#pragma unroll
                    for (int n = 0; n < 2; ++n) xb[k][bj][n] = *(const f32x4*)(sp + colb + bj * 128 + n * 16);
            }
            asm volatile("" ::: "memory");
#pragma unroll
            for (int k = 0; k < MK_RB; ++k) {
                const int rg = t * MK_RB + k, ai = rg >> 2, m = rg & 3, row = u.pm * 256 + ai * 128 + wr * 64 + m * 16 + fr;
                float* d = (row < MX) ? dstX + (size_t)row * DM : dstC + (size_t)(row - MX) * DM;
                float part = 0.f;
#pragma unroll
                for (int bj = 0; bj < 2; ++bj)
#pragma unroll
                    for (int n = 0; n < 2; ++n) {
                        const int col = colb + bj * 128 + n * 16;
                        const f32x4 x4 = xb[k][bj][n] + g4[bj][n] * acc[ai][bj][m][n];
                        *(f32x4*)(d + col) = x4;
                        if (emit) { part += (x4[0] * x4[0] + x4[1] * x4[1]) + (x4[2] * x4[2] + x4[3] * x4[3]);
                            const f32x4 o = x4 * gm[bj][n]; u32x2 w; w.x = pkh2(o[0], o[1]); w.y = pkh2(o[2], o[3]); *(u32x2*)(XN + (size_t)row * DM + col) = w; }
                    }
                if (emit) { part += __shfl_xor(part, 16); part += __shfl_xor(part, 32); if (fq == 0) unsafeAtomicAdd(ssq + row, part); }
            }
            asm volatile("" ::: "memory");
        }
    }
};

struct CtxSplitOrder {
    int G, c;
    __device__ __forceinline__ bool next(int i, pg8::Unit& u) const {
        const int L = i * G + c; if (L >= 256) return false;
        const int tile = L >> 3, ks = L & 7;
        u.pm = 64 + (tile >> 2); u.pn = tile & 3;
        const int st = (ks < 6) ? 6 * ks : 36 + 4 * (ks - 6);
        u.ko = st * 128; u.nt = (ks < 6) ? 6 : 4; return true;
    }
    __device__ __forceinline__ void a_ready(const pg8::Unit&) const {}
    __device__ __forceinline__ void done(const pg8::Unit&) const {}
};
struct EpiPartial {
    static constexpr bool PERM = true, AFTER_DRAIN = false;
    h16* PART;
    __device__ __forceinline__ void operator()(const f32x4 (&acc)[2][2][4][2], const pg8::Unit& u, int wr, int wc, int fr, int fq) const {
        const int ks = (u.ko < 36 * 128) ? u.ko / (6 * 128) : 6 + (u.ko - 36 * 128) / (4 * 128);
        h16* base = PART + (size_t)ks * MC * DM;
#pragma unroll
        for (int ai = 0; ai < 2; ++ai)
#pragma unroll
            for (int m = 0; m < 4; ++m) {
                const int row = (u.pm - 64) * 256 + ai * 128 + wr * 64 + m * 16 + fr;
#pragma unroll
                for (int bj = 0; bj < 2; ++bj) {
                    const f32x4 v0 = acc[ai][bj][m][0], v1 = acc[ai][bj][m][1];
                    u32x4 w; w.x = pkh2(v0[0], v0[1]); w.y = pkh2(v0[2], v0[3]); w.z = pkh2(v1[0], v1[1]); w.w = pkh2(v1[2], v1[3]);
                    *(u32x4*)(base + (size_t)row * DM + u.pn * 256 + bj * 128 + wc * 32 + 8 * fq) = w;
                }
            }
    }
};
__device__ __forceinline__ void ctx_fix_rows(int gw, int NGW, int lane, float* __restrict__ CR, const h16* __restrict__ PART, const float* __restrict__ gate  ,
                                             h16* __restrict__ XN, const float* __restrict__ ng, const float* __restrict__ scl  , float* __restrict__ ssq) {
    asm volatile("" : "+v"(lane));
    for (int r = gw; r < MC; r += NGW) {
        float ss = 0.f;
#pragma unroll
        for (int j = 0; j < 2; ++j) {
            const int col = 8 * (lane + 64 * j);
            f32x4 a0 = {0.f, 0.f, 0.f, 0.f}, a1 = {0.f, 0.f, 0.f, 0.f};
#pragma unroll
            for (int ks = 0; ks < 8; ++ks) { const h8 p = *(const h8*)(PART + ((size_t)ks * MC + r) * DM + col);
                a0 += (f32x4){(float)p[0], (float)p[1], (float)p[2], (float)p[3]}; a1 += (f32x4){(float)p[4], (float)p[5], (float)p[6], (float)p[7]}; }
            float* xp = CR + (size_t)r * DM + col;
            const f32x4 x0 = *(const f32x4*)xp + *(const f32x4*)(gate + col) * a0, x1 = *(const f32x4*)(xp + 4) + *(const f32x4*)(gate + col + 4) * a1;
            *(f32x4*)xp = x0; *(f32x4*)(xp + 4) = x1;
            ss += (x0[0] * x0[0] + x0[1] * x0[1]) + (x0[2] * x0[2] + x0[3] * x0[3]) + (x1[0] * x1[0] + x1[1] * x1[1]) + (x1[2] * x1[2] + x1[3] * x1[3]);
            const f32x4 o0 = x0 * *(const f32x4*)(ng + col) * (*(const f32x4*)(scl + col) + 1.f), o1 = x1 * *(const f32x4*)(ng + col + 4) * (*(const f32x4*)(scl + col + 4) + 1.f);
            u32x4 w; w.x = pkh2(o0[0], o0[1]); w.y = pkh2(o0[2], o0[3]); w.z = pkh2(o1[0], o1[1]); w.w = pkh2(o1[2], o1[3]);
            *(u32x4*)(XN + (size_t)(MX + r) * DM + col) = w;
        }
        ss = wave_sum(ss);
        if (lane == 0) ssq[MX + r] = ss;
    }
}

template <bool PLAIN> struct EpiSwigluT {
    static constexpr bool PERM = true, AFTER_DRAIN = false;
    h16* H; LAS unsigned char* ldsb; mutable int ne;
    __device__ __forceinline__ void operator()(const f32x4 (&acc)[2][2][4][2], const pg8::Unit& u, int wr, int wc, int fr, int fq) const {
        const int col0 = u.pn * 128 + wc * 32 + 8 * fq;
        const LAS float* slot = (const LAS float*)(ldsb + PF_OFF + (ne & 1) * PF_SLOT); ne += 1;
        const LAS float* sp = slot + 256 + wc * 32 + 8 * fq;
        const f32x4 sg0 = *(const LAS f32x4*)sp, sg1 = *(const LAS f32x4*)(sp + 4), su0 = *(const LAS f32x4*)(sp + 128), su1 = *(const LAS f32x4*)(sp + 132);
#pragma unroll
        for (int ai = 0; ai < 2; ++ai)
#pragma unroll
            for (int m = 0; m < 4; ++m) {
                const int row = u.pm * 256 + ai * 128 + wr * 64 + m * 16 + fr;
                const float rs = __builtin_amdgcn_rsqf(slot[ai * 128 + wr * 64 + m * 16 + fr] * (1.f / DM) + EPS);
                const f32x4 g0 = PLAIN ? acc[ai][0][m][0] : acc[ai][0][m][0] * rs + sg0, g1 = PLAIN ? acc[ai][0][m][1] : acc[ai][0][m][1] * rs + sg1, u0 = PLAIN ? acc[ai][1][m][0] : acc[ai][1][m][0] * rs + su0, u1 = PLAIN ? acc[ai][1][m][1] : acc[ai][1][m][1] * rs + su1;
                u32x4 w;
                w.x = pkh2(silu_f(g0[0]) * u0[0], silu_f(g0[1]) * u0[1]); w.y = pkh2(silu_f(g0[2]) * u0[2], silu_f(g0[3]) * u0[3]);
                w.z = pkh2(silu_f(g1[0]) * u1[0], silu_f(g1[1]) * u1[1]); w.w = pkh2(silu_f(g1[2]) * u1[2], silu_f(g1[3]) * u1[3]);
                store16_wt(H + (size_t)row * FF + col0, w);
            }
    }
};

__device__ __forceinline__ int wt_row(int map, int n) {
    if (map == 1) {
        if (n < 384) { const int d = n & 63; return (n & ~63) + 2 * (d & 31) + (d >> 5); }
        if (n >= 1024 && n < 1536) { const int d = n & 31; return (n & ~31) + 2 * (d & 15) + (d >> 4); }
        return n;
    }
    if (map == 2) return 256 * (n >> 7) + (n & 127);
    if (map == 3) return 256 * (n >> 7) + 128 + (n & 127);
    return n;
}
__device__ __forceinline__ void p0_transpose_item(const float* __restrict__ W, int K, int N, h16* __restrict__ WT, int map, LAS float* scr, int item, int lane) {
    const int nblk = N / 32, kb = item / nblk, nb = item % nblk, k0 = 64 * kb, n0 = 32 * nb;
#pragma unroll 8
    for (int i = 0; i < 32; ++i) { const int kk = 2 * i + (lane >> 5); scr[kk * 33 + (lane & 31)] = W[(size_t)(k0 + kk) * N + n0 + (lane & 31)]; }
    asm volatile("s_waitcnt lgkmcnt(0)" ::: "memory");
    const int c = lane & 7;
#pragma unroll
    for (int j = 0; j < 4; ++j) { const int n = (lane >> 3) + 8 * j; const LAS float* s = scr + (8 * c) * 33 + n;
        u32x4 o; o.x = pkh2(s[0 * 33], s[1 * 33]); o.y = pkh2(s[2 * 33], s[3 * 33]); o.z = pkh2(s[4 * 33], s[5 * 33]); o.w = pkh2(s[6 * 33], s[7 * 33]);
        *(u32x4*)(WT + (size_t)wt_row(map, n0 + n) * K + k0 + 8 * c) = o; }
    asm volatile("s_waitcnt lgkmcnt(0)" ::: "memory");
}

__device__ __forceinline__ void p0_ada_task(const float* __restrict__ cvec, const float* __restrict__ cctx, const float* __restrict__ w_ada, const float* __restrict__ b_ada,
                                            float* __restrict__ MOD, int task, int lane, const float osc) {
    const int l = task / (96 * 8), ct = (task >> 3) % 96, kc = task & 7;
    const int n = ct * 64 + lane, k0 = kc * 128;
    float a0 = 0.f, a1 = 0.f, a2 = 0.f, a3 = 0.f, a4 = 0.f, a5 = 0.f, a6 = 0.f, a7 = 0.f, a8 = 0.f;
    const float* wp = w_ada + ((size_t)l * DM + k0) * MODW + n;
    for (int hf = 0; hf < 2; ++hf) {
        const int k = k0 + 64 * hf + lane;
        const float s0 = silu_f(cvec[0 * DM + k]), s1 = silu_f(cvec[1 * DM + k]), s2 = silu_f(cvec[2 * DM + k]), s3 = silu_f(cvec[3 * DM + k]);
        const float s4 = silu_f(cvec[4 * DM + k]), s5 = silu_f(cvec[5 * DM + k]), s6 = silu_f(cvec[6 * DM + k]), s7 = silu_f(cvec[7 * DM + k]);
        const float s8 = silu_f(cctx[k]);
        float wv[64];
#pragma unroll
        for (int kk = 0; kk < 64; ++kk) wv[kk] = wp[(size_t)(64 * hf + kk) * MODW];
#define RL(x, kk) __uint_as_float((unsigned)__builtin_amdgcn_readlane((int)__float_as_uint(x), kk))
#pragma unroll
        for (int kk = 0; kk < 64; ++kk) {
            const float w = wv[kk];
            a0 += RL(s0, kk) * w; a1 += RL(s1, kk) * w; a2 += RL(s2, kk) * w; a3 += RL(s3, kk) * w; a4 += RL(s4, kk) * w;
            a5 += RL(s5, kk) * w; a6 += RL(s6, kk) * w; a7 += RL(s7, kk) * w; a8 += RL(s8, kk) * w;
        }
#undef RL
    }
    if (kc == 0) { const float bb = b_ada[l * MODW + n]; a0 += bb; a1 += bb; a2 += bb; a3 += bb; a4 += bb; a5 += bb; a6 += bb; a7 += bb; a8 += bb; }
    a0 *= osc; a1 *= osc; a2 *= osc; a3 *= osc; a4 *= osc; a5 *= osc; a6 *= osc; a7 *= osc; a8 *= osc;
    float* mp = MOD + (size_t)l * 9 * MODW + n;
    unsafeAtomicAdd(mp + 0 * MODW, a0); unsafeAtomicAdd(mp + 1 * MODW, a1); unsafeAtomicAdd(mp + 2 * MODW, a2); unsafeAtomicAdd(mp + 3 * MODW, a3); unsafeAtomicAdd(mp + 4 * MODW, a4);
    unsafeAtomicAdd(mp + 5 * MODW, a5); unsafeAtomicAdd(mp + 6 * MODW, a6); unsafeAtomicAdd(mp + 7 * MODW, a7); unsafeAtomicAdd(mp + 8 * MODW, a8);
}

__device__ __forceinline__ void prep_rows(int gw, int NGW, int lane, const float* __restrict__ srcX, const float* __restrict__ srcC, h16* __restrict__ XN,
                                          const float* __restrict__ g, const float* __restrict__ modl, int scaleoff, float* __restrict__ ssq, int M) {
    asm volatile("" : "+v"(lane));
    for (int row = gw; row < M; row += NGW) {
        const bool isx = row < MX; const int bidx = isx ? (row >> 11) : 8;
        const f32x4* s = (const f32x4*)(isx ? srcX + (size_t)row * DM : srcC + (size_t)(row - MX) * DM);
        f32x4 v[4]; float ss = 0.f;
#pragma unroll
        for (int j = 0; j < 4; ++j) { v[j] = s[lane + 64 * j]; ss += (v[j][0] * v[j][0] + v[j][1] * v[j][1]) + (v[j][2] * v[j][2] + v[j][3] * v[j][3]); }
        ss = wave_sum(ss);
        if (lane == 0) ssq[row] = ss;
        const float* mb = modl + bidx * MODW;
#pragma unroll
        for (int j = 0; j < 4; ++j) {
            const int col = 4 * (lane + 64 * j);
            const f32x4 g4 = *(const f32x4*)(g + col), sc4 = *(const f32x4*)(mb + scaleoff + col);
            const f32x4 o = v[j] * g4 * (sc4 + 1.f);
            u32x2 w; w.x = pkh2(o[0], o[1]); w.y = pkh2(o[2], o[3]);
            *(u32x2*)(XN + (size_t)row * DM + col) = w;
        }
    }
}
__device__ __forceinline__ void shw_block_task(LAS unsigned char* lds, const h16* __restrict__ Wt  , const float* __restrict__ modl, int shiftoff, float* __restrict__ shw_p0) {
    int tid_ = threadIdx.x; asm volatile("" : "+v"(tid_));
    const int tid = tid_, lane = tid & 63, w = tid >> 6;
    LAS float* sh = (LAS float*)lds;
    LAS float* red = (LAS float*)(lds + 40960);
    for (int i = tid; i < 9 * 256; i += 512) { const int b = i >> 8, c4 = (i & 255) * 4; *(LAS f32x4*)(sh + b * 1024 + c4) = *(const f32x4*)(modl + b * MODW + shiftoff + c4); }
    __syncthreads();
    float acc[9];
#pragma unroll
    for (int b = 0; b < 9; ++b) acc[b] = 0.f;
    const h16* wp = Wt + (size_t)lane * DM + 128 * w;
#pragma unroll 2
    for (int kk = 0; kk < 128; kk += 8) {
        const h8 wv = *(const h8*)(wp + kk);
        float wf[8];
#pragma unroll
        for (int e = 0; e < 8; ++e) wf[e] = (float)wv[e];
#pragma unroll
        for (int b = 0; b < 9; ++b) {
            const f32x4 s0 = *(const LAS f32x4*)(sh + b * 1024 + 128 * w + kk), s1 = *(const LAS f32x4*)(sh + b * 1024 + 128 * w + kk + 4);
            acc[b] += (s0[0] * wf[0] + s0[1] * wf[1]) + (s0[2] * wf[2] + s0[3] * wf[3]) + (s1[0] * wf[4] + s1[1] * wf[5]) + (s1[2] * wf[6] + s1[3] * wf[7]);
        }
    }
#pragma unroll
    for (int b = 0; b < 9; ++b) red[(w * 9 + b) * 64 + lane] = acc[b];
    __syncthreads();
    for (int i = tid; i < 9 * 64; i += 512) { const int b = i >> 6, r = i & 63; float d = 0.f;
#pragma unroll
        for (int ww = 0; ww < 8; ++ww) d += red[(ww * 9 + b) * 64 + r];
        shw_p0[b * SHWW + r] = d; }
    __syncthreads();
}
__device__ __forceinline__ void final_norm_rows(int gw, int NGW, int lane, float* __restrict__ X, const float* __restrict__ g) {
    asm volatile("" : "+v"(lane));
    for (int row = gw; row < MX; row += NGW) {
        f32x4* s = (f32x4*)(X + (size_t)row * DM);
        f32x4 v[4]; float ss = 0.f;
#pragma unroll
        for (int j = 0; j < 4; ++j) { v[j] = s[lane + 64 * j]; ss += (v[j][0] * v[j][0] + v[j][1] * v[j][1]) + (v[j][2] * v[j][2] + v[j][3] * v[j][3]); }
        const float r = 1.0f / sqrtf(wave_sum(ss) * (1.f / DM) + EPS);
#pragma unroll
        for (int j = 0; j < 4; ++j) { const f32x4 g4 = *(const f32x4*)(g + 4 * (lane + 64 * j)); s[lane + 64 * j] = (v[j] * r) * g4; }
    }
}

constexpr int KROW = 144;
constexpr int KT_BYTES = 64 * KROW;
constexpr int ATT_BIAS_OFF = 4 * KT_BYTES;

__device__ __forceinline__ float max3f(float a, float b, float c) { float r; asm("v_max3_f32 %0, %1, %2, %3" : "=v"(r) : "v"(a), "v"(b), "v"(c)); return r; }
__device__ __forceinline__ float xmax32(float v) { auto rr = __builtin_amdgcn_permlane32_swap(__float_as_uint(v), __float_as_uint(v), false, false); return fmaxf(__uint_as_float(rr[0]), __uint_as_float(rr[1])); }
__device__ __forceinline__ float xsum32(float v) { auto rr = __builtin_amdgcn_permlane32_swap(__float_as_uint(v), __float_as_uint(v), false, false); return __uint_as_float(rr[0]) + __uint_as_float(rr[1]); }
constexpr float SM_THR = 8.f;
__device__ __forceinline__ void softmax_step(f32x16& s0, f32x16& s1, float& mh, float& l, f32x16& ng, f32x16 (&O)[2], const bool first, h8 (&p)[4]) {
    float mx = max3f(s0[0], s1[0], s0[1]);
    mx = max3f(mx, s1[1], s0[2]); mx = max3f(mx, s1[2], s0[3]); mx = max3f(mx, s1[3], s0[4]); mx = max3f(mx, s1[4], s0[5]);
    mx = max3f(mx, s1[5], s0[6]); mx = max3f(mx, s1[6], s0[7]); mx = max3f(mx, s1[7], s0[8]); mx = max3f(mx, s1[8], s0[9]);
    mx = max3f(mx, s1[9], s0[10]); mx = max3f(mx, s1[10], s0[11]); mx = max3f(mx, s1[11], s0[12]); mx = max3f(mx, s1[12], s0[13]);
    mx = max3f(mx, s1[13], s0[14]); mx = max3f(mx, s1[14], s0[15]); mx = fmaxf(mx, s1[15]);
    mx = xmax32(mx);
    if (__builtin_expect(first || __any(mx > SM_THR), 0)) {
        asm volatile("" ::: "memory");
        const float dl = first ? mx : fmaxf(mx, 0.f);
        mh += dl;
#pragma unroll
        for (int r = 0; r < 16; ++r) { s0[r] -= dl; s1[r] -= dl; ng[r] = -mh; }
        if (!first) { const float f = ex2(-dl); l *= f; O[0] = O[0] * f; O[1] = O[1] * f; }
    }
    f32x2 acc = {0.f, 0.f};
#pragma unroll
    for (int r = 0; r < 16; r += 2) { s0[r] = ex2(s0[r]); s0[r + 1] = ex2(s0[r + 1]); s1[r] = ex2(s1[r]); s1[r + 1] = ex2(s1[r + 1]);
        acc += (f32x2){s0[r], s0[r + 1]}; acc += (f32x2){s1[r], s1[r + 1]}; }
    l += acc[0] + acc[1];
#pragma unroll
    for (int e = 0; e < 8; ++e) { p[0][e] = (h16)s0[e]; p[1][e] = (h16)s0[8 + e]; p[2][e] = (h16)s1[e]; p[3][e] = (h16)s1[8 + e]; }
}

__device__ __forceinline__ void softmax_step_raw(f32x16& s0, f32x16& s1, float& mh, float& l, f32x16 (&O)[2], const bool first, h8 (&p)[4]) {
    float mx = max3f(s0[0], s1[0], s0[1]);
    mx = max3f(mx, s1[1], s0[2]); mx = max3f(mx, s1[2], s0[3]); mx = max3f(mx, s1[3], s0[4]); mx = max3f(mx, s1[4], s0[5]);
    mx = max3f(mx, s1[5], s0[6]); mx = max3f(mx, s1[6], s0[7]); mx = max3f(mx, s1[7], s0[8]); mx = max3f(mx, s1[8], s0[9]);
    mx = max3f(mx, s1[9], s0[10]); mx = max3f(mx, s1[10], s0[11]); mx = max3f(mx, s1[11], s0[12]); mx = max3f(mx, s1[12], s0[13]);
    mx = max3f(mx, s1[13], s0[14]); mx = max3f(mx, s1[14], s0[15]); mx = fmaxf(mx, s1[15]);
    mx = xmax32(mx) - mh;
    if (__builtin_expect(first || __any(mx > SM_THR), 0)) {
        asm volatile("" ::: "memory");
        const float dl = first ? mx : fmaxf(mx, 0.f);
        mh += dl;
        if (!first) { const float f = ex2(-dl); l *= f; O[0] = O[0] * f; O[1] = O[1] * f; }
    }
    f32x2 acc = {0.f, 0.f};
#pragma unroll
    for (int r = 0; r < 16; r += 2) { s0[r] = ex2(s0[r] - mh); s0[r + 1] = ex2(s0[r + 1] - mh); s1[r] = ex2(s1[r] - mh); s1[r + 1] = ex2(s1[r + 1] - mh);
        acc += (f32x2){s0[r], s0[r + 1]}; acc += (f32x2){s1[r], s1[r + 1]}; }
    l += acc[0] + acc[1];
#pragma unroll
    for (int e = 0; e < 8; ++e) { p[0][e] = (h16)s0[e]; p[1][e] = (h16)s0[8 + e]; p[2][e] = (h16)s1[e]; p[3][e] = (h16)s1[8 + e]; }
}

template <int MODE>
__device__ __forceinline__ void attn_unit(LAS unsigned char* lds, const h16* __restrict__ PRJ, h16* __restrict__ Y, const int b, const int sub, const int blk, const bool ctxq,
                                          const float* __restrict__ sinkp, const float* __restrict__ rpb, const float lam, const float lam_init, const float* __restrict__ subg) {
    int tid_ = threadIdx.x; asm volatile("" : "+v"(tid_));
    const int tid = tid_, lane = tid & 63, wid = __builtin_amdgcn_readfirstlane(tid >> 6), q = lane & 31, hi = lane >> 5;
    int qrow0 = 0, qcol = 0, kcol = 0, vcol = 0, ycol = 0, lt0 = 0, lt1 = 0, qpos0 = 0, rsq = 0, qr = 0; float sinkv = 0.f;
    const int ctxrow0 = MX + b * CTXL, latrow0 = b * SEQ;
    if (MODE == 0) {
        int head;
        if (!ctxq) { const int g = sub; head = 2 * g + (wid >> 2); qpos0 = 128 * blk + 32 * (wid & 3); qrow0 = latrow0 + qpos0; lt0 = max(0, 2 * (blk - 1)); lt1 = min(32, 2 * (blk + 2)); kcol = 256 + 64 * g; vcol = 384 + 64 * g; }
        else { head = sub; qrow0 = ctxrow0 + 32 * wid; kcol = 256 + 64 * (head >> 1); vcol = 384 + 64 * (head >> 1); }
        qcol = 64 * head; ycol = 64 * head; sinkv = sinkp[head] * LOG2E;
    } else if (MODE == 1) {
        const int h = sub; qcol = 1024 + 64 * h; kcol = 1280 + 64 * h; vcol = 1536 + 64 * h; ycol = 512 + 64 * h;
        if (!ctxq) { qpos0 = 256 * blk + 32 * wid; qrow0 = latrow0 + qpos0; lt0 = 0; lt1 = 32; } else { qrow0 = ctxrow0 + 32 * wid; }
    } else {
        const int h = sub; qcol = 1792 + 64 * h; kcol = 2048 + 64 * h; vcol = 2304 + 64 * h; ycol = 768 + 64 * h;
        if (!ctxq) { const int r0 = 4 * blk; qr = r0 + (wid >> 1); qpos0 = 64 * qr + 32 * (wid & 1); qrow0 = latrow0 + qpos0; rsq = min(max(qr - 4, 0), 24);
                     lt0 = min(max(r0 - 4, 0), 24); lt1 = min(max(r0 - 1, 0), 24) + 8; }
        else { qrow0 = ctxrow0 + 32 * wid; }
    }
    const int nt = 4 + (lt1 - lt0);
    LAS float* bl = (LAS float*)(lds + ATT_BIAS_OFF);
    if (MODE == 2 && !ctxq) { for (int i = tid; i < 465; i += 512) bl[i] = rpb[sub * 465 + i] * LOG2E; }
    unsigned dvm = 0u; int dboff = 0;
    if (MODE == 2) { const int qc = (qpos0 + q) & 63, cs = min(max(qc - 8, 0), 48); dboff = 4 * (8 * hi - qc + 15);
#pragma unroll
        for (int e = 0; e < 32; ++e) { const int kc = 32 * (e >> 4) + 16 * ((e & 15) >> 3) + (e & 7) + 8 * hi; if (kc >= cs && kc < cs + 16) dvm |= 1u << e; } }

    h8 qf[4];
#pragma unroll
    for (int c = 0; c < 4; ++c) qf[c] = *(const h8*)(PRJ + (size_t)(qrow0 + q) * INW + qcol + 16 * c + 8 * hi);

    const int skr = tid >> 3, skc = tid & 7, svk = tid & 63, svd = tid >> 6;
    u32x4 kreg, vreg;
#define ATT_LOAD(j) do { const int krow0_ = ((j) < 4) ? ctxrow0 + 64 * (j) : latrow0 + 64 * (lt0 + (j) - 4); \
        kreg = *(const u32x4*)(PRJ + (size_t)(krow0_ + skr) * INW + kcol + 8 * skc); vreg = *(const u32x4*)(PRJ + (size_t)(krow0_ + svk) * INW + vcol + 8 * svd); } while (0)
#define ATT_STORE(bufi) do { LAS unsigned char* kb_ = lds + (bufi) * 2 * KT_BYTES; *(LAS u32x4*)(kb_ + skr * KROW + skc * 16) = kreg; \
        LAS unsigned short* vb_ = (LAS unsigned short*)(kb_ + KT_BYTES + (8 * svd) * KROW) + svk; \
        vb_[0 * (KROW / 2)] = (unsigned short)(vreg.x & 0xffffu); vb_[1 * (KROW / 2)] = (unsigned short)(vreg.x >> 16); \
        vb_[2 * (KROW / 2)] = (unsigned short)(vreg.y & 0xffffu); vb_[3 * (KROW / 2)] = (unsigned short)(vreg.y >> 16); \
        vb_[4 * (KROW / 2)] = (unsigned short)(vreg.z & 0xffffu); vb_[5 * (KROW / 2)] = (unsigned short)(vreg.z >> 16); \
        vb_[6 * (KROW / 2)] = (unsigned short)(vreg.w & 0xffffu); vb_[7 * (KROW / 2)] = (unsigned short)(vreg.w >> 16); } while (0)
    ATT_LOAD(0); ATT_STORE(0);
    __syncthreads();

    float m1 = 0.f, l1 = 0.f, m2 = 0.f, l2 = 0.f;
    f32x16 O1[2], O2[2], ng1 = f32x16{}, ng2 = f32x16{};
#pragma unroll
    for (int dt = 0; dt < 2; ++dt) { O1[dt] = f32x16{}; O2[dt] = f32x16{}; }
    const int pi = (q & ~12) | ((q & 4) << 1) | ((q & 8) >> 1);

    for (int j = 0; j < nt; ++j) {
        if (j + 1 < nt) ATT_LOAD(j + 1);
        const LAS unsigned char* Kb = lds + (j & 1) * 2 * KT_BYTES; const LAS unsigned char* Vb = Kb + KT_BYTES;
        bool active = true; int kr = 0;
        if (MODE == 2 && j >= 4) { kr = lt0 + j - 4; active = (kr >= rsq) && (kr < rsq + 8); }
        if (active) {
            const LAS unsigned char* kp = Kb + pi * KROW + hi * 16;
            h8 p1[4];
            {
                f32x16 sA[2];
#pragma unroll
                for (int hf = 0; hf < 2; ++hf) {
#pragma unroll
                    for (int c = 0; c < (MODE == 1 ? 2 : 4); ++c) {
                        const h8 kf = *(const LAS h8*)(kp + hf * 32 * KROW + c * 32);
                        if (c == 0) sA[hf] = __builtin_amdgcn_mfma_f32_32x32x16_f16(kf, qf[c], ng1, 0, 0, 0);
                        else sA[hf] = __builtin_amdgcn_mfma_f32_32x32x16_f16(kf, qf[c], sA[hf], 0, 0, 0);
                    }
                }
                if (j >= 4) {
                    if (MODE == 0) {
                        const int dq = qpos0 + q - 64 * (lt0 + j - 4) - 8 * hi;
#pragma unroll
                        for (int hf = 0; hf < 2; ++hf)
#pragma unroll
                            for (int r = 0; r < 16; ++r) { const int df = dq - (32 * hf + 16 * (r >> 3) + (r & 7)); if (df > 128 || df < -128) sA[hf][r] = -1e30f; }
                    }
                    if (MODE == 2) {
                        const LAS unsigned char* bb = (const LAS unsigned char*)bl + (kr - qr + 7) * 124 + dboff;
                        constexpr int NEGB = (int)0xF149F2CAu;
                        unsigned dv = dvm; asm volatile("" : "+v"(dv));
#pragma unroll
                        for (int hf = 0; hf < 2; ++hf)
#pragma unroll
                            for (int r = 0; r < 16; ++r) { const float bv = *(const LAS float*)(bb + 4 * (32 * hf + 16 * (r >> 3) + (r & 7)));
                                const int M = ((int)(dv << (31 - (hf * 16 + r)))) >> 31;
                                sA[hf][r] = __int_as_float((__float_as_int(sA[hf][r] + bv) & M) | (NEGB & ~M)); }
                    }
                }
                softmax_step(sA[0], sA[1], m1, l1, ng1, O1, j == 0, p1);
            }
            const LAS unsigned char* vp = Vb + q * KROW + hi * 16;
#pragma unroll
            for (int dt = 0; dt < 2; ++dt)
#pragma unroll
                for (int c = 0; c < 4; ++c) {
                    const h8 vf = *(const LAS h8*)(vp + dt * 32 * KROW + c * 32);
                    O1[dt] = __builtin_amdgcn_mfma_f32_32x32x16_f16(vf, p1[c], O1[dt], 0, 0, 0);
                }
            if (MODE == 1) {
                __builtin_amdgcn_sched_barrier(0);
                f32x16 sB[2]; h8 p2[4];
#pragma unroll
                for (int hf = 0; hf < 2; ++hf) {
#pragma unroll
                    for (int c = 2; c < 4; ++c) {
                        const h8 kf = *(const LAS h8*)(kp + hf * 32 * KROW + c * 32);
                        if (c == 2) sB[hf] = __builtin_amdgcn_mfma_f32_32x32x16_f16(kf, qf[c], ng2, 0, 0, 0);
                        else sB[hf] = __builtin_amdgcn_mfma_f32_32x32x16_f16(kf, qf[c], sB[hf], 0, 0, 0);
                    }
                }
                softmax_step(sB[0], sB[1], m2, l2, ng2, O2, j == 0, p2);
#pragma unroll
                for (int dt = 0; dt < 2; ++dt)
#pragma unroll
                    for (int c = 0; c < 4; ++c) {
                        const h8 vf = *(const LAS h8*)(vp + dt * 32 * KROW + c * 32);
                        O2[dt] = __builtin_amdgcn_mfma_f32_32x32x16_f16(vf, p2[c], O2[dt], 0, 0, 0);
                    }
            }
        }
        if (j + 1 < nt) ATT_STORE((j + 1) & 1);
        __syncthreads();
    }
#undef ATT_LOAD
#undef ATT_STORE
    h16* yrow = Y + (size_t)(qrow0 + q) * DM + ycol;
    if (MODE != 1) {
        float lt = xsum32(l1);
        if (MODE == 0) lt += ex2(sinkv - m1);
        const float inv = 1.f / lt;
#pragma unroll
        for (int dt = 0; dt < 2; ++dt)
#pragma unroll
            for (int g4 = 0; g4 < 4; ++g4) { u32x2 w; w.x = pkh2(O1[dt][4 * g4] * inv, O1[dt][4 * g4 + 1] * inv); w.y = pkh2(O1[dt][4 * g4 + 2] * inv, O1[dt][4 * g4 + 3] * inv);
                *(u32x2*)(yrow + 32 * dt + 8 * g4 + 4 * hi) = w; }
    } else {
        const float i1 = 1.f / xsum32(l1), i2 = lam / xsum32(l2);
        float ss = 0.f;
#pragma unroll
        for (int dt = 0; dt < 2; ++dt)
#pragma unroll
            for (int r = 0; r < 16; ++r) { const float o = O1[dt][r] * i1 - O2[dt][r] * i2; O1[dt][r] = o; ss += o * o; }
        ss = xsum32(ss);
        const float rr = __builtin_amdgcn_rsqf(ss * (1.f / 64.f) + EPS) * (1.f - lam_init);
#pragma unroll
        for (int dt = 0; dt < 2; ++dt)
#pragma unroll
            for (int g4 = 0; g4 < 4; ++g4) { const int d0 = 32 * dt + 8 * g4 + 4 * hi; const f32x4 sg = *(const f32x4*)(subg + d0);
                u32x2 w; w.x = pkh2(O1[dt][4 * g4] * rr * sg[0], O1[dt][4 * g4 + 1] * rr * sg[1]); w.y = pkh2(O1[dt][4 * g4 + 2] * rr * sg[2], O1[dt][4 * g4 + 3] * rr * sg[3]);
                *(u32x2*)(yrow + d0) = w; }
    }
}

__device__ __forceinline__ void conv_unit(LAS unsigned char* lds, const h16* __restrict__ PRJ, h16* __restrict__ Y, int seqrow0, int seqlen, int t0,
                                          const float* __restrict__ cw, const float* __restrict__ cb, const float* __restrict__ lg, const float* __restrict__ lb) {
    int tid_ = threadIdx.x; asm volatile("" : "+v"(tid_));
    const int tid = tid_, lane = tid & 63, wid = tid >> 6;
    LAS float* hb = (LAS float*)lds;
    LAS float* ob = hb + 62 * 256;
    for (int task = tid; task < 62 * 32; task += 512) {
        const int r = task >> 5, c8 = (task & 31) * 8, t = t0 - 15 + r;
        f32x4 o0 = {0.f, 0.f, 0.f, 0.f}, o1 = {0.f, 0.f, 0.f, 0.f};
        if (t >= 0 && t < seqlen) {
            const h16* rp = PRJ + (size_t)(seqrow0 + t) * INW + 512 + c8;
            const h8 a = *(const h8*)rp, g = *(const h8*)(rp + 256);
#pragma unroll
            for (int e = 0; e < 4; ++e) { o0[e] = (float)a[e] * __builtin_amdgcn_rcpf(1.f + ex2(-(float)g[e] * LOG2E)); o1[e] = (float)a[4 + e] * __builtin_amdgcn_rcpf(1.f + ex2(-(float)g[4 + e] * LOG2E)); }
        }
        *(LAS f32x4*)(hb + r * 256 + c8) = o0; *(LAS f32x4*)(hb + r * 256 + c8 + 4) = o1;
    }
    __syncthreads();
    {
        const int c = tid & 255, th = tid >> 8;
        float w[31];
#pragma unroll
        for (int k = 0; k < 31; ++k) w[k] = cw[k * 256 + c];
        float acc[16];
        const float bias = cb[c];
#pragma unroll
        for (int o = 0; o < 16; ++o) acc[o] = bias;
#pragma unroll
        for (int ir = 0; ir < 46; ++ir) {
            const float v = hb[(16 * th + ir) * 256 + c];
#pragma unroll
            for (int o = 0; o < 16; ++o) { const int k = ir - o; if (k >= 0 && k < 31) acc[o] += v * w[k]; }
        }
#pragma unroll
        for (int o = 0; o < 16; ++o) ob[(16 * th + o) * 256 + c] = acc[o];
    }
    __syncthreads();
#pragma unroll
    for (int tt = 0; tt < 4; ++tt) {
        const int tok = 4 * wid + tt;
        const f32x4 v = *(const LAS f32x4*)(ob + tok * 256 + 4 * lane);
        const float mean = wave_sum((v[0] + v[1]) + (v[2] + v[3])) * (1.f / 256.f);
        const f32x4 d = v - mean;
        const float var = wave_sum((d[0] * d[0] + d[1] * d[1]) + (d[2] * d[2] + d[3] * d[3])) * (1.f / 256.f);
        const float rstd = __builtin_amdgcn_rsqf(var + EPS);
        const f32x4 g4 = *(const f32x4*)(lg + 4 * lane), b4 = *(const f32x4*)(lb + 4 * lane);
        const f32x4 o = d * rstd * g4 + b4;
        u32x2 wv; wv.x = pkh2(silu_f(o[0]), silu_f(o[1])); wv.y = pkh2(silu_f(o[2]), silu_f(o[3]));
        *(u32x2*)(Y + (size_t)(seqrow0 + t0 + tok) * DM + 256 + 4 * lane) = wv;
    }
    __syncthreads();
}

constexpr size_t WS_BAR = 768 * 1024;
#define XB_TMO      128
#define XB_XCNT(j)  (256  + 64 * (j))
#define XB_XSUB(j)  (1280 + 64 * (j))
#define XB_XGEN(j)  (2304 + 64 * (j))
#define XB_TOP      3328
#define XB_TOPGEN   3392
#define XCD_BAR_WORDS 3456
#define XB_SPIN_CAP (1u << 18)

__device__ __forceinline__ unsigned xb_ld(unsigned* p)              { return __hip_atomic_load(p, __ATOMIC_RELAXED, __HIP_MEMORY_SCOPE_AGENT); }
__device__ __forceinline__ unsigned xb_add(unsigned* p, unsigned v) { return __hip_atomic_fetch_add(p, v, __ATOMIC_RELAXED, __HIP_MEMORY_SCOPE_AGENT); }
__device__ __forceinline__ unsigned xb_xcc_id() { return (unsigned)__builtin_amdgcn_s_getreg((3 << 11) | 20) & 0xFu; }
#define XB_SPIN(cond, bar) do { unsigned _sp = 0; while (cond) { __builtin_amdgcn_s_sleep(1); \
    if ((++_sp & 255u) == 0u) { if (xb_ld(&(bar)[XB_TMO])) break; if (_sp > XB_SPIN_CAP) { atomicAdd(&(bar)[XB_TMO], 1u); break; } } } } while (0)

struct XcdBarrier {
    unsigned* bar; unsigned x;
    volatile LAS unsigned* st;
};

__device__ __forceinline__ XcdBarrier xcd_barrier_post(unsigned* bar, volatile LAS unsigned* st) {
    XcdBarrier b; b.bar = bar; b.x = xb_xcc_id(); b.st = st;
    if (threadIdx.x == 0) (void)xb_add(&bar[XB_XCNT(b.x)], 1u);
    return b;
}
__device__ __forceinline__ void xcd_barrier_complete(unsigned* bar, unsigned x, unsigned& nloc, unsigned& nx) {
    const unsigned G = gridDim.x * gridDim.y * gridDim.z;
    unsigned sum, cnt, mine, sp = 0u;
    for (;;) {
        sum = 0u; cnt = 0u; mine = 0u;
#pragma unroll
        for (unsigned j = 0; j < 16; ++j) { const unsigned c = xb_ld(&bar[XB_XCNT(j)]); sum += c; cnt += (c > 0u) ? 1u : 0u; mine = (j == x) ? c : mine; }
        if (sum == G) break;
        __builtin_amdgcn_s_sleep(1);
        if ((++sp & 255u) == 0u) { if (xb_ld(&bar[XB_TMO])) break; if (sp > XB_SPIN_CAP) { atomicAdd(&bar[XB_TMO], 1u); break; } }
    }
    nloc = mine > 0u ? mine : 1u; nx = cnt > 0u ? cnt : 1u;
}

__device__ __forceinline__ void xcd_barrier(const XcdBarrier& b) {
    asm volatile("s_waitcnt vmcnt(0)" ::: "memory");
    __syncthreads();
    if (threadIdx.x == 0) {
        unsigned* bar = b.bar;
        __builtin_amdgcn_s_waitcnt(0);
        unsigned nloc = b.st[0], nx = b.st[1];
        if (nloc == 0u) { xcd_barrier_complete(bar, b.x, nloc, nx); b.st[0] = nloc; b.st[1] = nx; }
        const unsigned old = xb_add(&bar[XB_XSUB(b.x)], 1u);
        const unsigned gen = old / nloc;
        if (old + 1u == (gen + 1u) * nloc) {
            __builtin_amdgcn_fence(__ATOMIC_RELEASE, "agent");
            asm volatile("s_waitcnt vmcnt(0)" ::: "memory");
            const unsigned og = xb_add(&bar[XB_TOP], 1u);
            const unsigned tg = og / nx;
            if (og + 1u == (tg + 1u) * nx) xb_add(&bar[XB_TOPGEN], 1u);
            else XB_SPIN(xb_ld(&bar[XB_TOPGEN]) == tg, bar);
            __builtin_amdgcn_fence(__ATOMIC_ACQUIRE, "agent");
            xb_add(&bar[XB_XGEN(b.x)], 1u);
            asm volatile("s_waitcnt vmcnt(0)" ::: "memory");
        } else {
            XB_SPIN(xb_ld(&bar[XB_XGEN(b.x)]) == gen, bar);
            __builtin_amdgcn_fence(__ATOMIC_ACQUIRE, "agent");
            asm volatile("s_waitcnt vmcnt(0)" ::: "memory");
        }
    }
    __syncthreads();
}

__device__ __forceinline__ void weight_item(int r, const float* __restrict__ wi, const float* __restrict__ wo, const float* __restrict__ wg, const float* __restrict__ wu, const float* __restrict__ wd,
                                            unsigned char* wb, LAS float* scr, int lane) {
    constexpr int I_IN = 16 * 80, I_OUT = 16 * 32, I_G = 16 * 88;
    if (r < I_IN) { p0_transpose_item(wi, DM, INW, (h16*)wb, 1, scr, r, lane); return; } r -= I_IN;
    if (r < I_OUT) { p0_transpose_item(wo, DM, DM, (h16*)(wb + WO_OFF), 0, scr, r, lane); return; } r -= I_OUT;
    if (r < I_G) { p0_transpose_item(wg, DM, FF, (h16*)(wb + WGU_OFF), 2, scr, r, lane); return; } r -= I_G;
    if (r < I_G) { p0_transpose_item(wu, DM, FF, (h16*)(wb + WGU_OFF), 3, scr, r, lane); return; } r -= I_G;
    p0_transpose_item(wd, FF, DM, (h16*)(wb + WD_OFF), 0, scr, r, lane);
}
constexpr int W_ITEMS = 16 * 80 + 16 * 32 + 2 * 16 * 88 + 44 * 32;

struct Args { const float* in[25]; float* out; unsigned char* ws; int ph_lo, ph_hi; };
constexpr int N_PHASES = 15;
constexpr int N_PHASES_OLD_ = 13;

__global__ void __launch_bounds__(512, 2) mega_fwd(Args a) {
    extern __shared__ __attribute__((aligned(16))) unsigned char lds_raw[];
    LAS unsigned char* lds = (LAS unsigned char*)lds_raw;
    cg::grid_group grid = cg::this_grid();
    int tid = threadIdx.x, lane = tid & 63; const int wave = __builtin_amdgcn_readfirstlane(tid >> 6);
    const int G = gridDim.x, blk = blockIdx.x;
    const int gw = blk * 8 + wave, NGW = G * 8;
    unsigned char* ws = a.ws;
    int zq = 0;
#define ZQ() asm volatile("" : "+s"(zq), "+v"(tid), "+v"(lane))
#define x_in (a.in[0 + zq])
#define c_in (a.in[1 + zq])
#define ctx_in (a.in[2 + zq])
#define cctx_in (a.in[3 + zq])
#define norm1_g (a.in[4 + zq])
#define norm2_g (a.in[5 + zq])
#define w_ada (a.in[6 + zq])
#define b_ada (a.in[7 + zq])
#define w_in (a.in[8 + zq])
#define w_out (a.in[9 + zq])
#define attn_sink (a.in[10 + zq])
#define conv_w (a.in[11 + zq])
#define conv_b (a.in[12 + zq])
#define conv_ln_g (a.in[13 + zq])
#define conv_ln_b (a.in[14 + zq])
#define lq1 (a.in[15 + zq])
#define lk1 (a.in[16 + zq])
#define lq2 (a.in[17 + zq])
#define lk2 (a.in[18 + zq])
#define subln_g (a.in[19 + zq])
#define na_rpb (a.in[20 + zq])
#define w_gate (a.in[21 + zq])
#define w_up (a.in[22 + zq])
#define w_down (a.in[23 + zq])
#define final_g (a.in[24 + zq])
    float* XO = a.out;
    float* MOD = (float*)(ws + WS_MOD);
    float2* ropeA = (float2*)(ws + WS_ROPEA); float2* ropeC = (float2*)(ws + WS_ROPEC);
    h16* XN = (h16*)(ws + WS_XN); float* CR = (float*)(ws + WS_CR); h16* PRJ = (h16*)(ws + WS_PRJ); h16* Y = (h16*)(ws + WS_Y); h16* H = (h16*)(ws + WS_H);
    const int lo = a.ph_lo, hi = a.ph_hi;
#ifndef MK_MASK
#define MK_MASK 0x1ff
#endif
#define IN(k) (lo <= (k) && (k) < hi)
#define INL(x) (((MK_MASK >> (x)) & 1) && IN(pb + (x)))
    volatile LAS unsigned* bst = (volatile LAS unsigned*)(lds + LDS_BYTES - 64);
    if (tid == 0) { bst[0] = 0u; bst[1] = 0u; }
    __syncthreads();
    if (a.ph_lo < 0) grid.sync();
    XcdBarrier xbar = xcd_barrier_post((unsigned*)(ws + WS_BAR), bst);
#define SEAM(k) do { if (IN(k) && IN((k) + 1)) { for (int rs_ = 0; rs_ < MK_REP_SYNC; ++rs_) xcd_barrier(xbar); } } while (0)

    if (((MK_MASK >> 7) & 1) && IN(0)) {
        ZQ();
        for (int rep_ = 0; rep_ < MK_REP_ADA; ++rep_) for (int t = gw; t < 96 * 8; t += NGW) p0_ada_task(c_in, cctx_in, w_ada, b_ada, MOD, t, lane, rep_ == 0 ? 1.f : 0.f);
        LAS float* scr = (LAS float*)(lds + wave * 16384);
        for (int rep_ = 0; rep_ < MK_REP_TR; ++rep_) for (int it = gw; it < W_ITEMS; it += NGW)
            weight_item(it, w_in, w_out, w_gate, w_up, w_down, ws + WS_W, scr, lane);
        for (int i = blk * 512 + tid; i < SEQ * 48; i += G * 512) {
            if (i < SEQ * 32) { const int t = i >> 5, f = i & 31; const float pos = (f < 16) ? (float)(t >> 6) : (float)(t & 63);
                const float inv = exp2f(-(float)(f & 15) * (13.287712379549449f / 16.f)); const float ang = pos * inv; ropeA[i] = make_float2(__cosf(ang), __sinf(ang)); }
            else { const int i2 = i - SEQ * 32; const int t = i2 >> 4, f = i2 & 15; const float pos = (f < 8) ? (float)(t >> 6) : (float)(t & 63);
                const float inv = exp2f(-(float)(f & 7) * (13.287712379549449f / 8.f)); const float ang = pos * inv; ropeC[i2] = make_float2(__cosf(ang), __sinf(ang)); }
        }
    }
    SEAM(0);
    float* SSQ = (float*)(ws + WS_SSQ);
    for (int rep_ = 0; rep_ < MK_REP_N1; ++rep_) if (((MK_MASK >> 7) & 1) && IN(1)) {
        ZQ();
        prep_rows(gw, NGW, lane, x_in, ctx_in, XN, norm1_g, MOD, 1 * DM, SSQ, MT);
        for (int t = blk; t < (SHWW / 64); t += G) {
            const int l = t >> 7, p0 = (t & 127) * 64;
            unsigned char* wb = ws + WS_W + (size_t)l * WS_WSTRIDE;
            const h16* wrow = (p0 < INW) ? (const h16*)wb + (size_t)p0 * DM : (const h16*)(wb + WGU_OFF) + (size_t)(p0 - INW) * DM;
            shw_block_task(lds, wrow, MOD + (size_t)l * 9 * MODW, (p0 < INW) ? 0 : 3 * DM, (float*)(wb + SHW_OFF) + p0);
        }
    }
    SEAM(1);

    for (int l = 0; l < 2; ++l) {
        const int pb = 2 + 6 * l;
        const bool ctx_needed = (l == 0);
        const float* modl = MOD + (size_t)l * 9 * MODW;
        unsigned char* wb = ws + WS_W + (size_t)l * WS_WSTRIDE;
#define srcX0 ((l == 0) ? x_in : (const float*)XO)
#define srcC0 ((l == 0) ? ctx_in : (const float*)CR)
        const int Mff = ctx_needed ? MT : MX;
        for (int rep_ = 0; rep_ < MK_REP_IN; ++rep_) if (INL(0)) {
            ZQ();
            pg8::Gemm g{(const pg8::bf16_t*)XN, (const pg8::bf16_t*)wb, MT, INW, DM};
            PrefOrder S; S.init(MT, INW, G, blk); S.ssq = SSQ + (size_t)(2 * l) * MT; S.shw = (const float*)(wb + SHW_OFF); S.ldsb = lds; S.na = 0;
            EpiInProj E{PRJ, ropeA, ropeC, lds, 0};
            pg8::gemm_phase<EpiInProj, PrefOrder, true, true>(lds, g, S, E);
        }
        SEAM(pb + 0);
        for (int rep_ = 0; rep_ < MK_REP_MIX; ++rep_) if (INL(1)) {
            ZQ();
            const float lam_init = 0.8f - 0.6f * expf(-0.3f * (float)l);
            float d1 = 0.f, d2 = 0.f;
            for (int i = 0; i < 32; ++i) { d1 += lq1[l * 32 + i] * lk1[l * 32 + i]; d2 += lq2[l * 32 + i] * lk2[l * 32 + i]; }
            const float lam = expf(d1) - expf(d2) + lam_init;
            const float* sinkp = attn_sink + l * 4; const float* rpb = na_rpb + l * 4 * 465; const float* subg = subln_g + l * 64;
#ifndef MK_CTX
#define MK_CTX 15
#endif
#ifndef MK_MIX
#define MK_MIX 0x1f
#endif
            const int nau = ctx_needed ? 288 : 256, ncu = ctx_needed ? 576 : 512;
            if (MK_MIX & 1) for (int w = blk; w < nau; w += G) { const bool cq = w >= 256; const int u = w & 255;
                attn_unit<1>(lds, PRJ, Y, cq ? (u >> 2) : (u >> 5), cq ? (u & 3) : ((u >> 3) & 3), cq ? 0 : (u & 7), cq, sinkp, rpb, lam, lam_init, subg); }
            asm volatile("" ::: "memory");
            if (MK_MIX & 2) for (int w = (blk + 32) % G; w < nau; w += G) { const bool cq = w >= 256; const int u = w & 255;
                attn_unit<0>(lds, PRJ, Y, cq ? (u >> 2) : (u >> 5), cq ? (u & 3) : ((u >> 4) & 1), cq ? 0 : (u & 15), cq, sinkp, rpb, lam, lam_init, subg); }
            asm volatile("" ::: "memory");
            if (MK_MIX & 4) for (int w = (blk + 64) % G; w < nau; w += G) { const bool cq = w >= 256; const int u = w & 255;
                attn_unit<2>(lds, PRJ, Y, cq ? (u >> 2) : (u >> 5), cq ? (u & 3) : ((u >> 3) & 3), cq ? 0 : (u & 7), cq, sinkp, rpb, lam, lam_init, subg); }
            asm volatile("" ::: "memory");
            if (MK_MIX & 8) for (int w = (blk + 96) % G; w < ncu; w += G) { const bool cq = w >= 512; const int v = w - 512;
                conv_unit(lds, PRJ, Y, cq ? MX + (v >> 3) * CTXL : (w >> 6) * SEQ, cq ? CTXL : SEQ, cq ? (v & 7) * 32 : (w & 63) * 32, conv_w + l * 31 * 256, conv_b + l * 256, conv_ln_g + l * 256, conv_ln_b + l * 256); }
        }
        SEAM(pb + 1);
        for (int rep_ = 0; rep_ < MK_REP_OUT; ++rep_) if (INL(2)) {
            ZQ();
            pg8::Gemm g{(const pg8::bf16_t*)Y, (const pg8::bf16_t*)(wb + WO_OFF), Mff, DM, DM}; pg8::StaticOrder S; S.init(Mff, DM, G, blk);
            EpiResid E{srcX0, srcC0, XO, CR, modl + 2 * DM, XN, norm2_g + l * DM, modl + 4 * DM, SSQ + (size_t)(2 * l + 1) * MT, (rep_ == MK_REP_OUT - 1) ? 1 : 0, (rep_ == MK_REP_OUT - 1) ? 1.f : 0.f};
            pg8::gemm_phase<EpiResid, pg8::StaticOrder, true, true>(lds, g, S, E);
            if (l == 0 && rep_ == MK_REP_OUT - 1) {
                const int nwg = (Mff / 256) * (DM / 256), rounds = (nwg + G - 1) / G, rem = nwg - (rounds - 1) * G;
                const int first = (rem < G) ? rem : 0, nidle = G - first;
                if (blk >= first) {
                    LAS float* scr = (LAS float*)(lds + wave * 16384);
                    for (int it = (blk - first) * 8 + wave; it < W_ITEMS; it += nidle * 8)
                        weight_item(it, w_in + (size_t)DM * INW, w_out + (size_t)DM * DM, w_gate + (size_t)DM * FF, w_up + (size_t)DM * FF, w_down + (size_t)FF * DM, ws + WS_W + WS_WSTRIDE, scr, lane);
                    for (int t = 96 * 8 + (blk - first) * 8 + wave; t < 2 * 96 * 8; t += nidle * 8) p0_ada_task(c_in, cctx_in, w_ada, b_ada, MOD, t, lane, 1.f);
                }
            }
        }
        SEAM(pb + 2);
        for (int rep_ = 0; rep_ < MK_REP_GU; ++rep_) if (INL(3)) {
            ZQ();
            pg8::Gemm g{(const pg8::bf16_t*)XN, (const pg8::bf16_t*)(wb + WGU_OFF), Mff, 2 * FF, DM};
            PrefOrder S; S.init(Mff, 2 * FF, G, blk); S.ssq = SSQ + (size_t)(2 * l + 1) * MT; S.shw = (const float*)(wb + SHW_OFF) + INW; S.ldsb = lds; S.na = 0;
#ifdef MK_GU_VARIANT
            if (rep_ == 0) { EpiSwigluT<true> E{H, lds, 0}; pg8::gemm_phase<EpiSwigluT<true>, PrefOrder, true, true>(lds, g, S, E); }
            else
#endif
            { EpiSwigluT<false> E{H, lds, 0}; pg8::gemm_phase<EpiSwigluT<false>, PrefOrder, true, true>(lds, g, S, E); }
        }
        SEAM(pb + 3);
        for (int rep_ = 0; rep_ < MK_REP_DN; ++rep_) if (INL(4)) {
            ZQ();
            {
                pg8::Gemm g{(const pg8::bf16_t*)H, (const pg8::bf16_t*)(wb + WD_OFF), MX, DM, FF}; pg8::StaticOrder S; S.init(MX, DM, G, blk);
                EpiResid E{XO, CR, XO, CR, modl + 5 * DM, XN, norm1_g + (l + 1 < 2 ? l + 1 : 1) * DM, MOD + (size_t)(l + 1 < 2 ? l + 1 : 1) * 9 * MODW + 1 * DM, SSQ + (size_t)(2 * (l + 1 < 2 ? l + 1 : 1)) * MT, (l == 0 && rep_ == MK_REP_DN - 1) ? 1 : 0, (rep_ == MK_REP_DN - 1) ? 1.f : 0.f};
                pg8::gemm_phase<EpiResid, pg8::StaticOrder, true, true>(lds, g, S, E);
            }
            if (ctx_needed) {
                pg8::Gemm g{(const pg8::bf16_t*)H, (const pg8::bf16_t*)(wb + WD_OFF), MT, DM, FF}; CtxSplitOrder S{G, blk};
                EpiPartial E{(h16*)(ws + WS_PART)};
                pg8::gemm_phase<EpiPartial, CtxSplitOrder, true, true>(lds, g, S, E);
            }
        }
        SEAM(pb + 4);
        if (ctx_needed) {
            if (INL(4) && IN(pb + 5)) { ZQ(); ctx_fix_rows(gw, NGW, lane, CR, (const h16*)(ws + WS_PART), modl + 5 * DM + 8 * MODW, XN, norm1_g + DM, MOD + (size_t)9 * MODW + 1 * DM + 8 * MODW, SSQ + (size_t)2 * MT);
                for (int t = blk; t < (SHWW / 64); t += G) {
                    const int p0 = t * 64;
                    unsigned char* wb1 = ws + WS_W + WS_WSTRIDE;
                    const h16* wrow = (p0 < INW) ? (const h16*)wb1 + (size_t)p0 * DM : (const h16*)(wb1 + WGU_OFF) + (size_t)(p0 - INW) * DM;
                    shw_block_task(lds, wrow, MOD + (size_t)9 * MODW, (p0 < INW) ? 0 : 3 * DM, (float*)(wb1 + SHW_OFF) + p0);
                } }
            SEAM(pb + 5);
        }
    }
    if (((MK_MASK >> 8) & 1) && IN(14)) { ZQ(); final_norm_rows(gw, NGW, lane, XO, final_g); }
#undef IN
#undef SEAM
#undef srcX0
#undef srcC0
#undef x_in
#undef c_in
#undef ctx_in
#undef cctx_in
#undef norm1_g
#undef norm2_g
#undef w_ada
#undef b_ada
#undef w_in
#undef w_out
#undef attn_sink
#undef conv_w
#undef conv_b
#undef conv_ln_g
#undef conv_ln_b
#undef lq1
#undef lk1
#undef lq2
#undef lk2
#undef subln_g
#undef na_rpb
#undef w_gate
#undef w_up
#undef w_down
#undef final_g
}

#ifndef MK_PER_PHASE
#define MK_PER_PHASE 0
#endif
extern "C" void kernel_launch(void* const* d_in, const int* in_sizes, int n_in, void* d_out, int out_size, void* d_ws, size_t ws_size, hipStream_t stream) {
    static int grid = 0;
    if (grid == 0) {
        int dev = 0, cus = 0, per_cu = 0;
        (void)hipGetDevice(&dev);
        (void)hipDeviceGetAttribute(&cus, hipDeviceAttributeMultiprocessorCount, dev);
        if (hipFuncSetAttribute((const void*)mega_fwd, hipFuncAttributeMaxDynamicSharedMemorySize, LDS_BYTES) != hipSuccess) fprintf(stderr, "kernel_launch: hipFuncSetAttribute failed\n");
        if (hipOccupancyMaxActiveBlocksPerMultiprocessor(&per_cu, (const void*)mega_fwd, 512, LDS_BYTES) != hipSuccess || per_cu < 1) { fprintf(stderr, "kernel_launch: occupancy query gave %d\n", per_cu); per_cu = 1; }
        (void)hipGetLastError();
        grid = cus * per_cu;
        if (n_in != 25 || ws_size < WS_END) fprintf(stderr, "kernel_launch: unexpected n_in %d / ws %zu\n", n_in, ws_size);
    }
    (void)hipMemsetAsync((char*)d_ws, 0, 1u << 20, stream);
    Args a{};
    for (int i = 0; i < 25; ++i) a.in[i] = (const float*)d_in[i];
    a.out = (float*)d_out; a.ws = (unsigned char*)d_ws;
#if MK_PER_PHASE
    for (int p = 0; p < N_PHASES; ++p) {
        a.ph_lo = p; a.ph_hi = p + 1;
        void* args[] = {&a};
        hipError_t e = hipLaunchCooperativeKernel((const void*)mega_fwd, dim3(grid), dim3(512), args, LDS_BYTES, stream);
        if (e != hipSuccess) { fprintf(stderr, "kernel_launch: launch of phase %d failed: %s (grid %d)\n", p, hipGetErrorString(e), grid); break; }
    }
#else
    a.ph_lo = 0; a.ph_hi = N_PHASES;
    void* args[] = {&a};
    hipError_t e = hipLaunchCooperativeKernel((const void*)mega_fwd, dim3(grid), dim3(512), args, LDS_BYTES, stream);
    if (e != hipSuccess) fprintf(stderr, "kernel_launch: cooperative launch failed: %s (grid %d)\n", hipGetErrorString(e), grid);
#endif
}
```

```cpp
#include <hip/hip_runtime.h>
#include <hip/hip_cooperative_groups.h>
#include <cstdio>
#include <cstdint>
namespace cg = cooperative_groups;
namespace pg8 {
#define PG8_LAS __attribute__((address_space(3)))
typedef unsigned short bf16_t;
typedef _Float16 bf16x8 __attribute__((ext_vector_type(8)));
typedef float f32x4 __attribute__((ext_vector_type(4)));
typedef unsigned u32x4 __attribute__((ext_vector_type(4)));
constexpr int BM = 256, BK = 64, HALF = 128, HTB = HALF * BK * 2  , STAGE_BYTES = 8 * HTB, NXCD = 8, WGM = 8;

__host__ __device__ __forceinline__ int lds_byte(int r, int c) { const int st = (r >> 4) * 2 + (c >> 5), rr = r & 15, cc = c & 31, ob = rr * 64 + cc * 2; return st * 1024 + (ob ^ (((ob >> 9) & 1) << 5)); }
__host__ __device__ __forceinline__ void stage_rc(int b, int& R, int& C) { const int st = b / 1024, sb = b % 1024, swz = sb ^ (((sb >> 9) & 1) << 5); R = (st >> 1) * 16 + swz / 64; C = (st & 1) * 32 + (swz % 64) / 2; }
__host__ __device__ __forceinline__ int perm32(int rho) { const int n = rho >> 4, i = rho & 15; return 8 * (i >> 2) + 4 * n + (i & 3); }

struct Unit { int pm, pn, ko, nt; };
struct Gemm { const bf16_t* A; const bf16_t* Bt; int M, N, K; };

struct StaticOrder {
    int nM, nN, nwg, G, c;
    __host__ __device__ void init(int M, int N, int G_, int c_) { nM = M / BM; nN = N / BM; nwg = nM * nN; G = G_; c = c_; }
    __host__ __device__ bool next(int i, Unit& u) const {
        const long L = (long)i * G + c; if (L >= nwg) return false;
        int wgid = (int)L; { const int q = nwg / NXCD, r = nwg % NXCD, xcd = wgid % NXCD, off = wgid / NXCD; wgid = (xcd < r ? xcd * (q + 1) : r * (q + 1) + (xcd - r) * q) + off; }
        const int nig = WGM * nN, gid = wgid / nig, fm = gid * WGM, gsz = (nM - fm) < WGM ? (nM - fm) : WGM;
        u.pm = fm + ((wgid % nig) % gsz); u.pn = (wgid % nig) / gsz; u.ko = 0; u.nt = 0; return true;
    }
    __device__ __forceinline__ void a_ready(const Unit&) const {}
    __device__ __forceinline__ void done(const Unit&) const {}
};

template <class Epi, class Sched, bool ALIGN_EPI = false, bool SP2 = false>
__device__ __forceinline__ void gemm_phase(PG8_LAS unsigned char* lds, const Gemm g, const Sched& S, const Epi& E) {
    int tid_l = threadIdx.x; asm volatile("" : "+v"(tid_l));
    const int tid = tid_l, wid = __builtin_amdgcn_readfirstlane(tid >> 6), lane = tid & 63, wr = wid >> 2, wc = wid & 3, fr = lane & 15, fq = lane >> 4;
    const int K = g.K; int nt = K / BK;
    unsigned voffA[2], voffB[2];
#pragma unroll
    for (int i = 0; i < 2; ++i) { int R, C; stage_rc(tid * 16 + i * 8192, R, C); const int Rb = Epi::PERM ? ((R & ~31) + perm32(R & 31)) : R;
        voffA[i] = (unsigned)(R * K + C) * 2u; voffB[i] = (unsigned)(Rb * K + C) * 2u; }
    const size_t kstep = (size_t)(BK * 2);
    const size_t hstep = (size_t)HALF * K * 2;
    const size_t tstep = 2 * hstep;
    const unsigned ldsw = (unsigned)wid * 1024u;
    const int aoff = lds_byte(wr * 64 + fr, fq * 8), boff = lds_byte(wc * 32 + fr, fq * 8);
#define PG8_SA(b, h) (((b) * 2 + (h)) * HTB)
#define PG8_SB(b, h) ((4 + (b) * 2 + (h)) * HTB)
#define PG8_STAGE(bufoff, gbase, voff) do { _Pragma("unroll") for (int _i = 0; _i < 2; ++_i) \
        __builtin_amdgcn_global_load_lds((const unsigned*)((const char*)(gbase) + (voff)[_i]), (PG8_LAS unsigned*)(lds + (bufoff) + ldsw + _i * 8192), 16, 0, 0); } while (0)
#define PG8_LDA(dst, b, h) do { _Pragma("unroll") for (int m = 0; m < 4; ++m) _Pragma("unroll") for (int k = 0; k < 2; ++k) dst[m][k] = *(const PG8_LAS bf16x8*)(lds + PG8_SA(b, h) + aoff + m * 2048 + k * 1024); } while (0)
#define PG8_LDB(dst, b, h) do { _Pragma("unroll") for (int n = 0; n < 2; ++n) _Pragma("unroll") for (int k = 0; k < 2; ++k) dst[n][k] = *(const PG8_LAS bf16x8*)(lds + PG8_SB(b, h) + boff + n * 2048 + k * 1024); } while (0)
#define PG8_MMA(ai, bj, At, Bt) do { __builtin_amdgcn_s_setprio(1); _Pragma("unroll") for (int m = 0; m < 4; ++m) _Pragma("unroll") for (int n = 0; n < 2; ++n) _Pragma("unroll") for (int k = 0; k < 2; ++k) \
        acc[ai][bj][m][n] = __builtin_amdgcn_mfma_f32_16x16x32_f16(Bt[n][k], At[m][k], acc[ai][bj][m][n], 0, 0, 0); __builtin_amdgcn_s_setprio(0); } while (0)
#define PG8_WAIT_V(n) asm volatile("s_waitcnt vmcnt(" #n ")" ::: "memory")
#define PG8_WAIT_L(n) asm volatile("s_waitcnt lgkmcnt(" #n ")" ::: "memory")
#define PG8_BAR __builtin_amdgcn_s_barrier()
#define PG8_SCHED __builtin_amdgcn_sched_barrier(0)
    Unit cur, nxt; int ui = 0;
    if (!S.next(0, cur)) return;
    if (cur.nt) nt = cur.nt;
    f32x4 acc[2][2][4][2];
#pragma unroll
    for (int a = 0; a < 2; ++a)
#pragma unroll
        for (int b = 0; b < 2; ++b)
#pragma unroll
            for (int m = 0; m < 4; ++m)
#pragma unroll
                for (int n = 0; n < 2; ++n) acc[a][b][m][n] = (f32x4){0.f, 0.f, 0.f, 0.f};
    bf16x8 At[4][2], B0[2][2], B1[2][2];
    const char* cA = (const char*)g.A + (size_t)cur.pm * tstep + cur.ko; const char* cB = (const char*)g.Bt + (size_t)cur.pn * tstep + cur.ko;
    S.a_ready(cur);
    if constexpr (SP2) {
        PG8_STAGE(PG8_SB(0, 0), cB, voffB); PG8_STAGE(PG8_SB(0, 1), cB + hstep, voffB); PG8_STAGE(PG8_SA(0, 0), cA, voffA); PG8_STAGE(PG8_SA(0, 1), cA + hstep, voffA);
        if (wr == 1) PG8_BAR;
        PG8_WAIT_V(2); PG8_BAR;
        PG8_STAGE(PG8_SB(1, 0), cB + kstep, voffB); PG8_STAGE(PG8_SA(1, 0), cA + kstep, voffA); PG8_STAGE(PG8_SB(1, 1), cB + hstep + kstep, voffB);
        PG8_WAIT_V(6); PG8_BAR;
    } else {
        PG8_STAGE(PG8_SB(0, 0), cB, voffB); PG8_STAGE(PG8_SA(0, 0), cA, voffA); PG8_STAGE(PG8_SB(0, 1), cB + hstep, voffB); PG8_STAGE(PG8_SA(0, 1), cA + hstep, voffA);
        if (wr == 1) PG8_BAR;
        PG8_WAIT_V(4); PG8_BAR;
        PG8_STAGE(PG8_SB(1, 0), cB + kstep, voffB); PG8_STAGE(PG8_SA(1, 0), cA + kstep, voffA); PG8_STAGE(PG8_SB(1, 1), cB + hstep + kstep, voffB);
        PG8_WAIT_V(6); PG8_BAR;
    }
    for (;;) {
        const bool has_next = S.next(ui + 1, nxt);
        const char* nA = has_next ? (const char*)g.A + (size_t)nxt.pm * tstep + nxt.ko : cA; const char* nB = has_next ? (const char*)g.Bt + (size_t)nxt.pn * tstep + nxt.ko : cB;
        for (int t = 0; t < nt; t += 2) {
            const bool last = (t == nt - 2);
            const char* a1 = cA + (size_t)(t + 1) * kstep;
            const char* a2 = last ? nA : cA + (size_t)(t + 2) * kstep; const char* b2 = last ? nB : cB + (size_t)(t + 2) * kstep;
            const char* a3 = a2 + kstep; const char* b3 = b2 + kstep;
            if (last && has_next) S.a_ready(nxt);
            if constexpr (SP2) {
            PG8_LDB(B0, 0, 0); PG8_LDB(B1, 0, 1); PG8_SCHED; PG8_LDA(At, 0, 0); PG8_STAGE(PG8_SA(1, 1), a1 + hstep, voffA);
            PG8_WAIT_V(8); PG8_WAIT_L(0); PG8_BAR; PG8_MMA(0, 0, At, B0); PG8_MMA(0, 1, At, B1); PG8_BAR; PG8_SCHED;
            PG8_LDA(At, 0, 1); PG8_STAGE(PG8_SB(0, 0), b2, voffB); PG8_STAGE(PG8_SB(0, 1), b2 + hstep, voffB); PG8_STAGE(PG8_SA(0, 0), a2, voffA);
            PG8_WAIT_V(8); PG8_WAIT_L(0); PG8_BAR; PG8_MMA(1, 0, At, B0); PG8_MMA(1, 1, At, B1); PG8_BAR; PG8_SCHED;
            PG8_LDB(B0, 1, 0); PG8_LDB(B1, 1, 1); PG8_SCHED; PG8_LDA(At, 1, 0); PG8_STAGE(PG8_SA(0, 1), a2 + hstep, voffA);
            PG8_WAIT_V(8); PG8_WAIT_L(0); PG8_BAR; PG8_MMA(0, 0, At, B0); PG8_MMA(0, 1, At, B1); PG8_BAR; PG8_SCHED;
            PG8_LDA(At, 1, 1); PG8_STAGE(PG8_SB(1, 0), b3, voffB); PG8_STAGE(PG8_SB(1, 1), b3 + hstep, voffB); PG8_STAGE(PG8_SA(1, 0), a3, voffA);
            PG8_WAIT_V(8); PG8_WAIT_L(0); PG8_BAR; PG8_MMA(1, 0, At, B0); PG8_MMA(1, 1, At, B1); PG8_BAR; PG8_SCHED;
            } else {
            PG8_LDB(B0, 0, 0); PG8_SCHED; PG8_LDA(At, 0, 0); PG8_STAGE(PG8_SA(1, 1), a1 + hstep, voffA);
            PG8_WAIT_L(8); PG8_BAR; PG8_WAIT_L(0); PG8_MMA(0, 0, At, B0); PG8_BAR; PG8_SCHED;
            PG8_LDB(B1, 0, 1); PG8_STAGE(PG8_SB(0, 0), b2, voffB);
            PG8_BAR; PG8_WAIT_L(0); PG8_MMA(0, 1, At, B1); PG8_BAR;
            PG8_LDA(At, 0, 1); PG8_STAGE(PG8_SA(0, 0), a2, voffA);
            PG8_BAR; PG8_WAIT_L(0); PG8_MMA(1, 0, At, B0); PG8_BAR; PG8_SCHED;
            PG8_STAGE(PG8_SB(0, 1), b2 + hstep, voffB);
            PG8_WAIT_V(6); PG8_BAR; PG8_MMA(1, 1, At, B1); PG8_BAR;
            PG8_LDB(B0, 1, 0); PG8_SCHED; PG8_LDA(At, 1, 0); PG8_STAGE(PG8_SA(0, 1), a2 + hstep, voffA);
            PG8_WAIT_L(8); PG8_BAR; PG8_WAIT_L(0); PG8_MMA(0, 0, At, B0); PG8_BAR; PG8_SCHED;
            PG8_LDB(B1, 1, 1); PG8_STAGE(PG8_SB(1, 0), b3, voffB);
            PG8_BAR; PG8_WAIT_L(0); PG8_MMA(0, 1, At, B1); PG8_BAR;
            PG8_LDA(At, 1, 1); PG8_STAGE(PG8_SA(1, 0), a3, voffA);
            PG8_BAR; PG8_WAIT_L(0); PG8_MMA(1, 0, At, B0); PG8_BAR; PG8_SCHED;
            PG8_STAGE(PG8_SB(1, 1), b3 + hstep, voffB);
            PG8_WAIT_V(6); PG8_BAR; PG8_MMA(1, 1, At, B1); PG8_BAR;
            }
        }
        if constexpr (ALIGN_EPI) { if (wr == 0) PG8_BAR; }
        if constexpr (!Epi::AFTER_DRAIN) { E(acc, cur, wr, wc, fr, fq); S.done(cur); }
        if (!has_next) break;
#pragma unroll
        for (int a = 0; a < 2; ++a)
#pragma unroll
            for (int b = 0; b < 2; ++b)
#pragma unroll
                for (int m = 0; m < 4; ++m)
#pragma unroll
                    for (int n = 0; n < 2; ++n) acc[a][b][m][n] = (f32x4){0.f, 0.f, 0.f, 0.f};
        cur = nxt; cA = nA; cB = nB; ++ui; nt = cur.nt ? cur.nt : K / BK;
        if constexpr (ALIGN_EPI) { if (wr == 1) PG8_BAR; }
    }
    PG8_WAIT_V(0);
    if constexpr (!ALIGN_EPI) { if (wr == 0) PG8_BAR; }
    PG8_BAR;
    if constexpr (Epi::AFTER_DRAIN) { E.fused(acc, cur, wr, wc, fr, fq, lds, wid, lane); S.done(cur); }
#undef PG8_SA
#undef PG8_SB
#undef PG8_STAGE
#undef PG8_LDA
#undef PG8_LDB
#undef PG8_MMA
#undef PG8_WAIT_V
#undef PG8_WAIT_L
#undef PG8_BAR
#undef PG8_SCHED
}
}

#ifndef MK_REP_GU
#define MK_REP_GU 1
#endif
#ifndef MK_REP_IN
#define MK_REP_IN 1
#endif
#ifndef MK_REP_SYNC
#define MK_REP_SYNC 1
#endif
#ifndef MK_REP_N1
#define MK_REP_N1 1
#endif
#ifndef MK_REP_TR
#define MK_REP_TR 1
#endif
#ifndef MK_REP_ADA
#define MK_REP_ADA 1
#endif
#ifndef MK_REP_OUT
#define MK_REP_OUT 1
#endif
#ifndef MK_REP_DN
#define MK_REP_DN 1
#endif
#ifndef MK_REP_MIX
#define MK_REP_MIX 1
#endif
constexpr int DM = 1024, NB = 8, SEQ = 2048, CTXL = 256;
constexpr int MX = NB * SEQ;
constexpr int MC = NB * CTXL;
constexpr int MT = MX + MC;
constexpr int INW = 2560, FF = 2816, MODW = 6 * DM;
constexpr float EPS = 1e-6f;
constexpr float LOG2E = 1.4426950408889634f;

#define LAS __attribute__((address_space(3)))
typedef _Float16 h16;
typedef _Float16 h8 __attribute__((ext_vector_type(8)));
typedef _Float16 h4 __attribute__((ext_vector_type(4)));
typedef _Float16 h2 __attribute__((ext_vector_type(2)));
typedef float f32x4 __attribute__((ext_vector_type(4)));
typedef float f32x2 __attribute__((ext_vector_type(2)));
typedef float f32x16 __attribute__((ext_vector_type(16)));
typedef unsigned u32x4 __attribute__((ext_vector_type(4)));
typedef unsigned u32x2 __attribute__((ext_vector_type(2)));

constexpr size_t MiB = 1u << 20;
constexpr size_t WS_MOD = 0;
constexpr size_t MOD_BYTES = (size_t)2 * 9 * MODW * 4;
constexpr size_t WS_ROPEA = 1 * MiB;
constexpr size_t WS_ROPEC = 1 * MiB + 512 * 1024;
constexpr size_t WS_W = 2 * MiB, WS_WSTRIDE = 24 * MiB;
constexpr size_t WO_OFF = 5 * MiB, WGU_OFF = 7 * MiB, WD_OFF = 18 * MiB;
constexpr size_t WS_XN = 50 * MiB;
constexpr size_t WS_CR = 86 * MiB;
constexpr size_t WS_PRJ = 94 * MiB;
constexpr size_t WS_Y = 184 * MiB;
constexpr size_t WS_H = 94 * MiB;
constexpr size_t WS_END = 252 * MiB;
constexpr size_t WS_PART = 220 * MiB;
constexpr size_t WS_SSQ = 448 * 1024;
constexpr size_t SHW_OFF = 23 * MiB + 512 * 1024;
constexpr int SHWW = 8192;

constexpr int LDS_BYTES = 147456;

__device__ __forceinline__ unsigned pkh2(float lo, float hi) { h2 v = {(h16)lo, (h16)hi}; return __builtin_bit_cast(unsigned, v); }
__device__ __forceinline__ float wave_sum(float v) {
#pragma unroll
    for (int o = 1; o < 64; o <<= 1) v += __shfl_xor(v, o);
    return v;
}
__device__ __forceinline__ float ex2(float x) { return __builtin_amdgcn_exp2f(x); }
__device__ __forceinline__ float silu_f(float g) { return g * __builtin_amdgcn_rcpf(1.f + ex2(-g * LOG2E)); }

#ifndef MK_WT
#define MK_WT 0
#endif
__device__ __forceinline__ void store16_wt(void* p, u32x4 v) {
#if MK_WT
    asm volatile("global_store_dwordx4 %0, %1, off sc1\n\ts_nop 1" :: "v"(p), "v"(v) : "memory");
#else
    *(u32x4*)p = v;
#endif
}
__device__ __forceinline__ f32x4 rot4(const f32x4 v, const f32x4 cs) { f32x4 o; o[0] = v[0] * cs[0] - v[1] * cs[1]; o[1] = v[0] * cs[1] + v[1] * cs[0]; o[2] = v[2] * cs[2] - v[3] * cs[3]; o[3] = v[2] * cs[3] + v[3] * cs[2]; return o; }

constexpr int PF_OFF = 131072, PF_SLOT = 2048;
struct PrefOrder : pg8::StaticOrder {
    const float* ssq; const float* shw; LAS unsigned char* ldsb; mutable int na;
    __device__ __forceinline__ void a_ready(const pg8::Unit& u) const {
        const int w = __builtin_amdgcn_readfirstlane(threadIdx.x >> 6), lane = threadIdx.x & 63;
        const int bidx = (u.pm < 64) ? (u.pm >> 3) : 8;
        const float* gp = (w < 4) ? ssq + u.pm * 256 + w * 64 + lane : shw + bidx * SHWW + u.pn * 256 + (w - 4) * 64 + lane;
        __builtin_amdgcn_global_load_lds((const unsigned*)gp, (LAS unsigned*)(ldsb + PF_OFF + (na & 1) * PF_SLOT + w * 256), 4, 0, 0);
        na += 1;
    }
};

struct EpiInProj {
    static constexpr bool PERM = true, AFTER_DRAIN = false;
    h16* PRJ; const float2* ropeA; const float2* ropeC; LAS unsigned char* ldsb; mutable int ne;
    __device__ __forceinline__ void operator()(const f32x4 (&acc)[2][2][4][2], const pg8::Unit& u, int wr, int wc, int fr, int fq) const {
        const LAS float* slot = (const LAS float*)(ldsb + PF_OFF + (ne & 1) * PF_SLOT); ne += 1;
#pragma unroll
        for (int bj = 0; bj < 2; ++bj) {
            const int hb = 2 * u.pn + bj;
            const int col0 = hb * 128 + wc * 32 + 8 * fq;
            const f32x4 sw0 = *(const LAS f32x4*)(slot + 256 + bj * 128 + wc * 32 + 8 * fq), sw1 = *(const LAS f32x4*)(slot + 256 + bj * 128 + wc * 32 + 8 * fq + 4);
            const int ropeMode = (hb <= 2) ? 1 : ((hb >= 8 && hb <= 11) ? 2 : 0);
            const float sc = (hb <= 1 || hb == 14 || hb == 15) ? 0.125f * LOG2E : ((hb == 8 || hb == 9) ? 0.17677669529663687f * LOG2E : 1.f);
#pragma unroll
            for (int ai = 0; ai < 2; ++ai)
#pragma unroll
                for (int m = 0; m < 4; ++m) {
                    const int row = u.pm * 256 + ai * 128 + wr * 64 + m * 16 + fr;
                    const float rs = __builtin_amdgcn_rsqf(slot[ai * 128 + wr * 64 + m * 16 + fr] * (1.f / DM) + EPS);
                    f32x4 v0 = acc[ai][bj][m][0] * rs + sw0, v1 = acc[ai][bj][m][1] * rs + sw1;
                    if (ropeMode != 0 && row < MX) {
                        const int t = row & (SEQ - 1);
                        const float2* tab = (ropeMode == 1) ? ropeA + t * 32 + (((wc * 32 + 8 * fq) & 63) >> 1) : ropeC + t * 16 + 4 * fq;
                        const f32x4 c01 = *(const f32x4*)tab, c23 = *(const f32x4*)(tab + 2);
                        v0 = rot4(v0, c01); v1 = rot4(v1, c23);
                    }
                    v0 = v0 * sc; v1 = v1 * sc;
                    u32x4 w; w.x = pkh2(v0[0], v0[1]); w.y = pkh2(v0[2], v0[3]); w.z = pkh2(v1[0], v1[1]); w.w = pkh2(v1[2], v1[3]);
                    store16_wt(PRJ + (size_t)row * INW + col0, w);
                    if (m & 1) asm volatile("" ::: "memory");
                }
        }
    }
};

struct EpiResid {
    static constexpr bool PERM = false, AFTER_DRAIN = false;
    const float* srcX; const float* srcC; float* dstX; float* dstC; const float* gate;
    h16* XN; const float* ng; const float* scl; float* ssq; int emit; float gsc;
    __device__ __forceinline__ void operator()(const f32x4 (&acc)[2][2][4][2], const pg8::Unit& u, int wr, int wc, int fr, int fq) const {
        const int bidx = (u.pm < 64) ? (u.pm >> 3) : 8;
        const int colb = u.pn * 256 + wc * 32 + 4 * fq;
        f32x4 g4[2][2], gm[2][2];
#pragma unroll
        for (int bj = 0; bj < 2; ++bj)
#pragma unroll
            for (int n = 0; n < 2; ++n) { const int col = colb + bj * 128 + n * 16; g4[bj][n] = *(const f32x4*)(gate + bidx * MODW + col) * gsc;
                gm[bj][n] = emit ? *(const f32x4*)(ng + col) * (*(const f32x4*)(scl + bidx * MODW + col) + 1.f) : (f32x4){0.f, 0.f, 0.f, 0.f}; }
#ifndef MK_RB
#define MK_RB 2
#endif
#pragma unroll
        for (int t = 0; t < 8 / MK_RB; ++t) {
            f32x4 xb[MK_RB][2][2];
#pragma unroll
            for (int k = 0; k < MK_RB; ++k) {
                const int rg = t * MK_RB + k, row = u.pm * 256 + (rg >> 2) * 128 + wr * 64 + (rg & 3) * 16 + fr;
                const float* sp = (row < MX) ? srcX + (size_t)row * DM : srcC + (size_t)(row - MX) * DM;
#pragma unroll
                for (int bj = 0; bj < 2; ++bj)
#pragma unroll
                    for (int n = 0; n < 2; ++n) xb[k][bj][n] = *(const f32x4*)(sp + colb + bj * 128 + n * 16);
            }
            asm volatile("" ::: "memory");
#pragma unroll
            for (int k = 0; k < MK_RB; ++k) {
                const int rg = t * MK_RB + k, ai = rg >> 2, m = rg & 3, row = u.pm * 256 + ai * 128 + wr * 64 + m * 16 + fr;
                float* d = (row < MX) ? dstX + (size_t)row * DM : dstC + (size_t)(row - MX) * DM;
                float part = 0.f;
#pragma unroll
                for (int bj = 0; bj < 2; ++bj)
#pragma unroll
                    for (int n = 0; n < 2; ++n) {
                        const int col = colb + bj * 128 + n * 16;
                        const f32x4 x4 = xb[k][bj][n] + g4[bj][n] * acc[ai][bj][m][n];
                        *(f32x4*)(d + col) = x4;
                        if (emit) { part += (x4[0] * x4[0] + x4[1] * x4[1]) + (x4[2] * x4[2] + x4[3] * x4[3]);
                            const f32x4 o = x4 * gm[bj][n]; u32x2 w; w.x = pkh2(o[0], o[1]); w.y = pkh2(o[2], o[3]); *(u32x2*)(XN + (size_t)row * DM + col) = w; }
                    }
                if (emit) { part += __shfl_xor(part, 16); part += __shfl_xor(part, 32); if (fq == 0) unsafeAtomicAdd(ssq + row, part); }
            }
            asm volatile("" ::: "memory");
        }
    }
};

struct CtxSplitOrder {
    int G, c;
    __device__ __forceinline__ bool next(int i, pg8::Unit& u) const {
        const int L = i * G + c; if (L >= 256) return false;
        const int tile = L >> 3, ks = L & 7;
        u.pm = 64 + (tile >> 2); u.pn = tile & 3;
        const int st = (ks < 6) ? 6 * ks : 36 + 4 * (ks - 6);
        u.ko = st * 128; u.nt = (ks < 6) ? 6 : 4; return true;
    }
    __device__ __forceinline__ void a_ready(const pg8::Unit&) const {}
    __device__ __forceinline__ void done(const pg8::Unit&) const {}
};
struct EpiPartial {
    static constexpr bool PERM = true, AFTER_DRAIN = false;
    h16* PART;
    __device__ __forceinline__ void operator()(const f32x4 (&acc)[2][2][4][2], const pg8::Unit& u, int wr, int wc, int fr, int fq) const {
        const int ks = (u.ko < 36 * 128) ? u.ko / (6 * 128) : 6 + (u.ko - 36 * 128) / (4 * 128);
        h16* base = PART + (size_t)ks * MC * DM;
#pragma unroll
        for (int ai = 0; ai < 2; ++ai)
#pragma unroll
            for (int m = 0; m < 4; ++m) {
                const int row = (u.pm - 64) * 256 + ai * 128 + wr * 64 + m * 16 + fr;
#pragma unroll
                for (int bj = 0; bj < 2; ++bj) {
                    const f32x4 v0 = acc[ai][bj][m][0], v1 = acc[ai][bj][m][1];
                    u32x4 w; w.x = pkh2(v0[0], v0[1]); w.y = pkh2(v0[2], v0[3]); w.z = pkh2(v1[0], v1[1]); w.w = pkh2(v1[2], v1[3]);
                    *(u32x4*)(base + (size_t)row * DM + u.pn * 256 + bj * 128 + wc * 32 + 8 * fq) = w;
                }
            }
    }
};
__device__ __forceinline__ void ctx_fix_rows(int gw, int NGW, int lane, float* __restrict__ CR, const h16* __restrict__ PART, const float* __restrict__ gate  ,
                                             h16* __restrict__ XN, const float* __restrict__ ng, const float* __restrict__ scl  , float* __restrict__ ssq) {
    asm volatile("" : "+v"(lane));
    for (int r = gw; r < MC; r += NGW) {
        float ss = 0.f;
#pragma unroll
        for (int j = 0; j < 2; ++j) {
            const int col = 8 * (lane + 64 * j);
            f32x4 a0 = {0.f, 0.f, 0.f, 0.f}, a1 = {0.f, 0.f, 0.f, 0.f};
#pragma unroll
            for (int ks = 0; ks < 8; ++ks) { const h8 p = *(const h8*)(PART + ((size_t)ks * MC + r) * DM + col);
                a0 += (f32x4){(float)p[0], (float)p[1], (float)p[2], (float)p[3]}; a1 += (f32x4){(float)p[4], (float)p[5], (float)p[6], (float)p[7]}; }
            float* xp = CR + (size_t)r * DM + col;
            const f32x4 x0 = *(const f32x4*)xp + *(const f32x4*)(gate + col) * a0, x1 = *(const f32x4*)(xp + 4) + *(const f32x4*)(gate + col + 4) * a1;
            *(f32x4*)xp = x0; *(f32x4*)(xp + 4) = x1;
            ss += (x0[0] * x0[0] + x0[1] * x0[1]) + (x0[2] * x0[2] + x0[3] * x0[3]) + (x1[0] * x1[0] + x1[1] * x1[1]) + (x1[2] * x1[2] + x1[3] * x1[3]);
            const f32x4 o0 = x0 * *(const f32x4*)(ng + col) * (*(const f32x4*)(scl + col) + 1.f), o1 = x1 * *(const f32x4*)(ng + col + 4) * (*(const f32x4*)(scl + col + 4) + 1.f);
            u32x4 w; w.x = pkh2(o0[0], o0[1]); w.y = pkh2(o0[2], o0[3]); w.z = pkh2(o1[0], o1[1]); w.w = pkh2(o1[2], o1[3]);
            *(u32x4*)(XN + (size_t)(MX + r) * DM + col) = w;
        }
        ss = wave_sum(ss);
        if (lane == 0) ssq[MX + r] = ss;
    }
}

template <bool PLAIN> struct EpiSwigluT {
    static constexpr bool PERM = true, AFTER_DRAIN = false;
    h16* H; LAS unsigned char* ldsb; mutable int ne;
    __device__ __forceinline__ void operator()(const f32x4 (&acc)[2][2][4][2], const pg8::Unit& u, int wr, int wc, int fr, int fq) const {
        const int col0 = u.pn * 128 + wc * 32 + 8 * fq;
        const LAS float* slot = (const LAS float*)(ldsb + PF_OFF + (ne & 1) * PF_SLOT); ne += 1;
        const LAS float* sp = slot + 256 + wc * 32 + 8 * fq;
        const f32x4 sg0 = *(const LAS f32x4*)sp, sg1 = *(const LAS f32x4*)(sp + 4), su0 = *(const LAS f32x4*)(sp + 128), su1 = *(const LAS f32x4*)(sp + 132);
#pragma unroll
        for (int ai = 0; ai < 2; ++ai)
#pragma unroll
            for (int m = 0; m < 4; ++m) {
                const int row = u.pm * 256 + ai * 128 + wr * 64 + m * 16 + fr;
                const float rs = __builtin_amdgcn_rsqf(slot[ai * 128 + wr * 64 + m * 16 + fr] * (1.f / DM) + EPS);
                const f32x4 g0 = PLAIN ? acc[ai][0][m][0] : acc[ai][0][m][0] * rs + sg0, g1 = PLAIN ? acc[ai][0][m][1] : acc[ai][0][m][1] * rs + sg1, u0 = PLAIN ? acc[ai][1][m][0] : acc[ai][1][m][0] * rs + su0, u1 = PLAIN ? acc[ai][1][m][1] : acc[ai][1][m][1] * rs + su1;
                u32x4 w;
                w.x = pkh2(silu_f(g0[0]) * u0[0], silu_f(g0[1]) * u0[1]); w.y = pkh2(silu_f(g0[2]) * u0[2], silu_f(g0[3]) * u0[3]);
                w.z = pkh2(silu_f(g1[0]) * u1[0], silu_f(g1[1]) * u1[1]); w.w = pkh2(silu_f(g1[2]) * u1[2], silu_f(g1[3]) * u1[3]);
                store16_wt(H + (size_t)row * FF + col0, w);
            }
    }
};

__device__ __forceinline__ int wt_row(int map, int n) {
    if (map == 1) {
        if (n < 384) { const int d = n & 63; return (n & ~63) + 2 * (d & 31) + (d >> 5); }
        if (n >= 1024 && n < 1536) { const int d = n & 31; return (n & ~31) + 2 * (d & 15) + (d >> 4); }
        return n;
    }
    if (map == 2) return 256 * (n >> 7) + (n & 127);
    if (map == 3) return 256 * (n >> 7) + 128 + (n & 127);
    return n;
}
__device__ __forceinline__ void p0_transpose_item(const float* __restrict__ W, int K, int N, h16* __restrict__ WT, int map, LAS float* scr, int item, int lane) {
    const int nblk = N / 32, kb = item / nblk, nb = item % nblk, k0 = 64 * kb, n0 = 32 * nb;
#pragma unroll 8
    for (int i = 0; i < 32; ++i) { const int kk = 2 * i + (lane >> 5); scr[kk * 33 + (lane & 31)] = W[(size_t)(k0 + kk) * N + n0 + (lane & 31)]; }
    asm volatile("s_waitcnt lgkmcnt(0)" ::: "memory");
    const int c = lane & 7;
#pragma unroll
    for (int j = 0; j < 4; ++j) { const int n = (lane >> 3) + 8 * j; const LAS float* s = scr + (8 * c) * 33 + n;
        u32x4 o; o.x = pkh2(s[0 * 33], s[1 * 33]); o.y = pkh2(s[2 * 33], s[3 * 33]); o.z = pkh2(s[4 * 33], s[5 * 33]); o.w = pkh2(s[6 * 33], s[7 * 33]);
        *(u32x4*)(WT + (size_t)wt_row(map, n0 + n) * K + k0 + 8 * c) = o; }
    asm volatile("s_waitcnt lgkmcnt(0)" ::: "memory");
}

__device__ __forceinline__ void p0_ada_task(const float* __restrict__ cvec, const float* __restrict__ cctx, const float* __restrict__ w_ada, const float* __restrict__ b_ada,
                                            float* __restrict__ MOD, int task, int lane, const float osc) {
    const int l = task / (96 * 8), ct = (task >> 3) % 96, kc = task & 7;
    const int n = ct * 64 + lane, k0 = kc * 128;
    float a0 = 0.f, a1 = 0.f, a2 = 0.f, a3 = 0.f, a4 = 0.f, a5 = 0.f, a6 = 0.f, a7 = 0.f, a8 = 0.f;
    const float* wp = w_ada + ((size_t)l * DM + k0) * MODW + n;
    for (int hf = 0; hf < 2; ++hf) {
        const int k = k0 + 64 * hf + lane;
        const float s0 = silu_f(cvec[0 * DM + k]), s1 = silu_f(cvec[1 * DM + k]), s2 = silu_f(cvec[2 * DM + k]), s3 = silu_f(cvec[3 * DM + k]);
        const float s4 = silu_f(cvec[4 * DM + k]), s5 = silu_f(cvec[5 * DM + k]), s6 = silu_f(cvec[6 * DM + k]), s7 = silu_f(cvec[7 * DM + k]);
        const float s8 = silu_f(cctx[k]);
        float wv[64];
#pragma unroll
        for (int kk = 0; kk < 64; ++kk) wv[kk] = wp[(size_t)(64 * hf + kk) * MODW];
#define RL(x, kk) __uint_as_float((unsigned)__builtin_amdgcn_readlane((int)__float_as_uint(x), kk))
#pragma unroll
        for (int kk = 0; kk < 64; ++kk) {
            const float w = wv[kk];
            a0 += RL(s0, kk) * w; a1 += RL(s1, kk) * w; a2 += RL(s2, kk) * w; a3 += RL(s3, kk) * w; a4 += RL(s4, kk) * w;
            a5 += RL(s5, kk) * w; a6 += RL(s6, kk) * w; a7 += RL(s7, kk) * w; a8 += RL(s8, kk) * w;
        }
#undef RL
    }
    if (kc == 0) { const float bb = b_ada[l * MODW + n]; a0 += bb; a1 += bb; a2 += bb; a3 += bb; a4 += bb; a5 += bb; a6 += bb; a7 += bb; a8 += bb; }
    a0 *= osc; a1 *= osc; a2 *= osc; a3 *= osc; a4 *= osc; a5 *= osc; a6 *= osc; a7 *= osc; a8 *= osc;
    float* mp = MOD + (size_t)l * 9 * MODW + n;
    unsafeAtomicAdd(mp + 0 * MODW, a0); unsafeAtomicAdd(mp + 1 * MODW, a1); unsafeAtomicAdd(mp + 2 * MODW, a2); unsafeAtomicAdd(mp + 3 * MODW, a3); unsafeAtomicAdd(mp + 4 * MODW, a4);
    unsafeAtomicAdd(mp + 5 * MODW, a5); unsafeAtomicAdd(mp + 6 * MODW, a6); unsafeAtomicAdd(mp + 7 * MODW, a7); unsafeAtomicAdd(mp + 8 * MODW, a8);
}

__device__ __forceinline__ void prep_rows(int gw, int NGW, int lane, const float* __restrict__ srcX, const float* __restrict__ srcC, h16* __restrict__ XN,
                                          const float* __restrict__ g, const float* __restrict__ modl, int scaleoff, float* __restrict__ ssq, int M) {
    asm volatile("" : "+v"(lane));
    for (int row = gw; row < M; row += NGW) {
        const bool isx = row < MX; const int bidx = isx ? (row >> 11) : 8;
        const f32x4* s = (const f32x4*)(isx ? srcX + (size_t)row * DM : srcC + (size_t)(row - MX) * DM);
        f32x4 v[4]; float ss = 0.f;
#pragma unroll
        for (int j = 0; j < 4; ++j) { v[j] = s[lane + 64 * j]; ss += (v[j][0] * v[j][0] + v[j][1] * v[j][1]) + (v[j][2] * v[j][2] + v[j][3] * v[j][3]); }
        ss = wave_sum(ss);
        if (lane == 0) ssq[row] = ss;
        const float* mb = modl + bidx * MODW;
#pragma unroll
        for (int j = 0; j < 4; ++j) {
            const int col = 4 * (lane + 64 * j);
            const f32x4 g4 = *(const f32x4*)(g + col), sc4 = *(const f32x4*)(mb + scaleoff + col);
            const f32x4 o = v[j] * g4 * (sc4 + 1.f);
            u32x2 w; w.x = pkh2(o[0], o[1]); w.y = pkh2(o[2], o[3]);
            *(u32x2*)(XN + (size_t)row * DM + col) = w;
        }
    }
}
__device__ __forceinline__ void shw_block_task(LAS unsigned char* lds, const h16* __restrict__ Wt  , const float* __restrict__ modl, int shiftoff, float* __restrict__ shw_p0) {
    int tid_ = threadIdx.x; asm volatile("" : "+v"(tid_));
    const int tid = tid_, lane = tid & 63, w = tid >> 6;
    LAS float* sh = (LAS float*)lds;
    LAS float* red = (LAS float*)(lds + 40960);
    for (int i = tid; i < 9 * 256; i += 512) { const int b = i >> 8, c4 = (i & 255) * 4; *(LAS f32x4*)(sh + b * 1024 + c4) = *(const f32x4*)(modl + b * MODW + shiftoff + c4); }
    __syncthreads();
    float acc[9];
#pragma unroll
    for (int b = 0; b < 9; ++b) acc[b] = 0.f;
    const h16* wp = Wt + (size_t)lane * DM + 128 * w;
#pragma unroll 2
    for (int kk = 0; kk < 128; kk += 8) {
        const h8 wv = *(const h8*)(wp + kk);
        float wf[8];
#pragma unroll
        for (int e = 0; e < 8; ++e) wf[e] = (float)wv[e];
#pragma unroll
        for (int b = 0; b < 9; ++b) {
            const f32x4 s0 = *(const LAS f32x4*)(sh + b * 1024 + 128 * w + kk), s1 = *(const LAS f32x4*)(sh + b * 1024 + 128 * w + kk + 4);
            acc[b] += (s0[0] * wf[0] + s0[1] * wf[1]) + (s0[2] * wf[2] + s0[3] * wf[3]) + (s1[0] * wf[4] + s1[1] * wf[5]) + (s1[2] * wf[6] + s1[3] * wf[7]);
        }
    }
#pragma unroll
    for (int b = 0; b < 9; ++b) red[(w * 9 + b) * 64 + lane] = acc[b];
    __syncthreads();
    for (int i = tid; i < 9 * 64; i += 512) { const int b = i >> 6, r = i & 63; float d = 0.f;
#pragma unroll
        for (int ww = 0; ww < 8; ++ww) d += red[(ww * 9 + b) * 64 + r];
        shw_p0[b * SHWW + r] = d; }
    __syncthreads();
}
__device__ __forceinline__ void final_norm_rows(int gw, int NGW, int lane, float* __restrict__ X, const float* __restrict__ g) {
    asm volatile("" : "+v"(lane));
    for (int row = gw; row < MX; row += NGW) {
        f32x4* s = (f32x4*)(X + (size_t)row * DM);
        f32x4 v[4]; float ss = 0.f;
#pragma unroll
        for (int j = 0; j < 4; ++j) { v[j] = s[lane + 64 * j]; ss += (v[j][0] * v[j][0] + v[j][1] * v[j][1]) + (v[j][2] * v[j][2] + v[j][3] * v[j][3]); }
        const float r = 1.0f / sqrtf(wave_sum(ss) * (1.f / DM) + EPS);
#pragma unroll
        for (int j = 0; j < 4; ++j) { const f32x4 g4 = *(const f32x4*)(g + 4 * (lane + 64 * j)); s[lane + 64 * j] = (v[j] * r) * g4; }
    }
}

constexpr int KROW = 144;
constexpr int KT_BYTES = 64 * KROW;
constexpr int ATT_BIAS_OFF = 4 * KT_BYTES;

__device__ __forceinline__ float max3f(float a, float b, float c) { float r; asm("v_max3_f32 %0, %1, %2, %3" : "=v"(r) : "v"(a), "v"(b), "v"(c)); return r; }
__device__ __forceinline__ float xmax32(float v) { auto rr = __builtin_amdgcn_permlane32_swap(__float_as_uint(v), __float_as_uint(v), false, false); return fmaxf(__uint_as_float(rr[0]), __uint_as_float(rr[1])); }
__device__ __forceinline__ float xsum32(float v) { auto rr = __builtin_amdgcn_permlane32_swap(__float_as_uint(v), __float_as_uint(v), false, false); return __uint_as_float(rr[0]) + __uint_as_float(rr[1]); }
constexpr float SM_THR = 8.f;
__device__ __forceinline__ void softmax_step(f32x16& s0, f32x16& s1, float& mh, float& l, f32x16& ng, f32x16 (&O)[2], const bool first, h8 (&p)[4]) {
    float mx = max3f(s0[0], s1[0], s0[1]);
    mx = max3f(mx, s1[1], s0[2]); mx = max3f(mx, s1[2], s0[3]); mx = max3f(mx, s1[3], s0[4]); mx = max3f(mx, s1[4], s0[5]);
    mx = max3f(mx, s1[5], s0[6]); mx = max3f(mx, s1[6], s0[7]); mx = max3f(mx, s1[7], s0[8]); mx = max3f(mx, s1[8], s0[9]);
    mx = max3f(mx, s1[9], s0[10]); mx = max3f(mx, s1[10], s0[11]); mx = max3f(mx, s1[11], s0[12]); mx = max3f(mx, s1[12], s0[13]);
    mx = max3f(mx, s1[13], s0[14]); mx = max3f(mx, s1[14], s0[15]); mx = fmaxf(mx, s1[15]);
    mx = xmax32(mx);
    if (__builtin_expect(first || __any(mx > SM_THR), 0)) {
        asm volatile("" ::: "memory");
        const float dl = first ? mx : fmaxf(mx, 0.f);
        mh += dl;
#pragma unroll
        for (int r = 0; r < 16; ++r) { s0[r] -= dl; s1[r] -= dl; ng[r] = -mh; }
        if (!first) { const float f = ex2(-dl); l *= f; O[0] = O[0] * f; O[1] = O[1] * f; }
    }
    f32x2 acc = {0.f, 0.f};
#pragma unroll
    for (int r = 0; r < 16; r += 2) { s0[r] = ex2(s0[r]); s0[r + 1] = ex2(s0[r + 1]); s1[r] = ex2(s1[r]); s1[r + 1] = ex2(s1[r + 1]);
        acc += (f32x2){s0[r], s0[r + 1]}; acc += (f32x2){s1[r], s1[r + 1]}; }
    l += acc[0] + acc[1];
#pragma unroll
    for (int e = 0; e < 8; ++e) { p[0][e] = (h16)s0[e]; p[1][e] = (h16)s0[8 + e]; p[2][e] = (h16)s1[e]; p[3][e] = (h16)s1[8 + e]; }
}

__device__ __forceinline__ void softmax_step_raw(f32x16& s0, f32x16& s1, float& mh, float& l, f32x16 (&O)[2], const bool first, h8 (&p)[4]) {
    float mx = max3f(s0[0], s1[0], s0[1]);
    mx = max3f(mx, s1[1], s0[2]); mx = max3f(mx, s1[2], s0[3]); mx = max3f(mx, s1[3], s0[4]); mx = max3f(mx, s1[4], s0[5]);
    mx = max3f(mx, s1[5], s0[6]); mx = max3f(mx, s1[6], s0[7]); mx = max3f(mx, s1[7], s0[8]); mx = max3f(mx, s1[8], s0[9]);
    mx = max3f(mx, s1[9], s0[10]); mx = max3f(mx, s1[10], s0[11]); mx = max3f(mx, s1[11], s0[12]); mx = max3f(mx, s1[12], s0[13]);
    mx = max3f(mx, s1[13], s0[14]); mx = max3f(mx, s1[14], s0[15]); mx = fmaxf(mx, s1[15]);
    mx = xmax32(mx) - mh;
    if (__builtin_expect(first || __any(mx > SM_THR), 0)) {
        asm volatile("" ::: "memory");
        const float dl = first ? mx : fmaxf(mx, 0.f);
        mh += dl;
        if (!first) { const float f = ex2(-dl); l *= f; O[0] = O[0] * f; O[1] = O[1] * f; }
    }
    f32x2 acc = {0.f, 0.f};
#pragma unroll
    for (int r = 0; r < 16; r += 2) { s0[r] = ex2(s0[r] - mh); s0[r + 1] = ex2(s0[r + 1] - mh); s1[r] = ex2(s1[r] - mh); s1[r + 1] = ex2(s1[r + 1] - mh);
        acc += (f32x2){s0[r], s0[r + 1]}; acc += (f32x2){s1[r], s1[r + 1]}; }
    l += acc[0] + acc[1];
#pragma unroll
    for (int e = 0; e < 8; ++e) { p[0][e] = (h16)s0[e]; p[1][e] = (h16)s0[8 + e]; p[2][e] = (h16)s1[e]; p[3][e] = (h16)s1[8 + e]; }
}

template <int MODE>
__device__ __forceinline__ void attn_unit(LAS unsigned char* lds, const h16* __restrict__ PRJ, h16* __restrict__ Y, const int b, const int sub, const int blk, const bool ctxq,
                                          const float* __restrict__ sinkp, const float* __restrict__ rpb, const float lam, const float lam_init, const float* __restrict__ subg) {
    int tid_ = threadIdx.x; asm volatile("" : "+v"(tid_));
    const int tid = tid_, lane = tid & 63, wid = __builtin_amdgcn_readfirstlane(tid >> 6), q = lane & 31, hi = lane >> 5;
    int qrow0 = 0, qcol = 0, kcol = 0, vcol = 0, ycol = 0, lt0 = 0, lt1 = 0, qpos0 = 0, rsq = 0, qr = 0; float sinkv = 0.f;
    const int ctxrow0 = MX + b * CTXL, latrow0 = b * SEQ;
    if (MODE == 0) {
        int head;
        if (!ctxq) { const int g = sub; head = 2 * g + (wid >> 2); qpos0 = 128 * blk + 32 * (wid & 3); qrow0 = latrow0 + qpos0; lt0 = max(0, 2 * (blk - 1)); lt1 = min(32, 2 * (blk + 2)); kcol = 256 + 64 * g; vcol = 384 + 64 * g; }
        else { head = sub; qrow0 = ctxrow0 + 32 * wid; kcol = 256 + 64 * (head >> 1); vcol = 384 + 64 * (head >> 1); }
        qcol = 64 * head; ycol = 64 * head; sinkv = sinkp[head] * LOG2E;
    } else if (MODE == 1) {
        const int h = sub; qcol = 1024 + 64 * h; kcol = 1280 + 64 * h; vcol = 1536 + 64 * h; ycol = 512 + 64 * h;
        if (!ctxq) { qpos0 = 256 * blk + 32 * wid; qrow0 = latrow0 + qpos0; lt0 = 0; lt1 = 32; } else { qrow0 = ctxrow0 + 32 * wid; }
    } else {
        const int h = sub; qcol = 1792 + 64 * h; kcol = 2048 + 64 * h; vcol = 2304 + 64 * h; ycol = 768 + 64 * h;
        if (!ctxq) { const int r0 = 4 * blk; qr = r0 + (wid >> 1); qpos0 = 64 * qr + 32 * (wid & 1); qrow0 = latrow0 + qpos0; rsq = min(max(qr - 4, 0), 24);
                     lt0 = min(max(r0 - 4, 0), 24); lt1 = min(max(r0 - 1, 0), 24) + 8; }
        else { qrow0 = ctxrow0 + 32 * wid; }
    }
    const int nt = 4 + (lt1 - lt0);
    LAS float* bl = (LAS float*)(lds + ATT_BIAS_OFF);
    if (MODE == 2 && !ctxq) { for (int i = tid; i < 465; i += 512) bl[i] = rpb[sub * 465 + i] * LOG2E; }
    unsigned dvm = 0u; int dboff = 0;
    if (MODE == 2) { const int qc = (qpos0 + q) & 63, cs = min(max(qc - 8, 0), 48); dboff = 4 * (8 * hi - qc + 15);
#pragma unroll
        for (int e = 0; e < 32; ++e) { const int kc = 32 * (e >> 4) + 16 * ((e & 15) >> 3) + (e & 7) + 8 * hi; if (kc >= cs && kc < cs + 16) dvm |= 1u << e; } }

    h8 qf[4];
#pragma unroll
    for (int c = 0; c < 4; ++c) qf[c] = *(const h8*)(PRJ + (size_t)(qrow0 + q) * INW + qcol + 16 * c + 8 * hi);

    const int skr = tid >> 3, skc = tid & 7, svk = tid & 63, svd = tid >> 6;
    u32x4 kreg, vreg;
#define ATT_LOAD(j) do { const int krow0_ = ((j) < 4) ? ctxrow0 + 64 * (j) : latrow0 + 64 * (lt0 + (j) - 4); \
        kreg = *(const u32x4*)(PRJ + (size_t)(krow0_ + skr) * INW + kcol + 8 * skc); vreg = *(const u32x4*)(PRJ + (size_t)(krow0_ + svk) * INW + vcol + 8 * svd); } while (0)
#define ATT_STORE(bufi) do { LAS unsigned char* kb_ = lds + (bufi) * 2 * KT_BYTES; *(LAS u32x4*)(kb_ + skr * KROW + skc * 16) = kreg; \
        LAS unsigned short* vb_ = (LAS unsigned short*)(kb_ + KT_BYTES + (8 * svd) * KROW) + svk; \
        vb_[0 * (KROW / 2)] = (unsigned short)(vreg.x & 0xffffu); vb_[1 * (KROW / 2)] = (unsigned short)(vreg.x >> 16); \
        vb_[2 * (KROW / 2)] = (unsigned short)(vreg.y & 0xffffu); vb_[3 * (KROW / 2)] = (unsigned short)(vreg.y >> 16); \
        vb_[4 * (KROW / 2)] = (unsigned short)(vreg.z & 0xffffu); vb_[5 * (KROW / 2)] = (unsigned short)(vreg.z >> 16); \
        vb_[6 * (KROW / 2)] = (unsigned short)(vreg.w & 0xffffu); vb_[7 * (KROW / 2)] = (unsigned short)(vreg.w >> 16); } while (0)
    ATT_LOAD(0); ATT_STORE(0);
    __syncthreads();

    float m1 = 0.f, l1 = 0.f, m2 = 0.f, l2 = 0.f;
    f32x16 O1[2], O2[2], ng1 = f32x16{}, ng2 = f32x16{};
#pragma unroll
    for (int dt = 0; dt < 2; ++dt) { O1[dt] = f32x16{}; O2[dt] = f32x16{}; }
    const int pi = (q & ~12) | ((q & 4) << 1) | ((q & 8) >> 1);

    for (int j = 0; j < nt; ++j) {
        if (j + 1 < nt) ATT_LOAD(j + 1);
        const LAS unsigned char* Kb = lds + (j & 1) * 2 * KT_BYTES; const LAS unsigned char* Vb = Kb + KT_BYTES;
        bool active = true; int kr = 0;
        if (MODE == 2 && j >= 4) { kr = lt0 + j - 4; active = (kr >= rsq) && (kr < rsq + 8); }
        if (active) {
            const LAS unsigned char* kp = Kb + pi * KROW + hi * 16;
            h8 p1[4];
            {
                f32x16 sA[2];
#pragma unroll
                for (int hf = 0; hf < 2; ++hf) {
#pragma unroll
                    for (int c = 0; c < (MODE == 1 ? 2 : 4); ++c) {
                        const h8 kf = *(const LAS h8*)(kp + hf * 32 * KROW + c * 32);
                        if (c == 0) sA[hf] = __builtin_amdgcn_mfma_f32_32x32x16_f16(kf, qf[c], ng1, 0, 0, 0);
                        else sA[hf] = __builtin_amdgcn_mfma_f32_32x32x16_f16(kf, qf[c], sA[hf], 0, 0, 0);
                    }
                }
                if (j >= 4) {
                    if (MODE == 0) {
                        const int dq = qpos0 + q - 64 * (lt0 + j - 4) - 8 * hi;
#pragma unroll
                        for (int hf = 0; hf < 2; ++hf)
#pragma unroll
                            for (int r = 0; r < 16; ++r) { const int df = dq - (32 * hf + 16 * (r >> 3) + (r & 7)); if (df > 128 || df < -128) sA[hf][r] = -1e30f; }
                    }
                    if (MODE == 2) {
                        const LAS unsigned char* bb = (const LAS unsigned char*)bl + (kr - qr + 7) * 124 + dboff;
                        constexpr int NEGB = (int)0xF149F2CAu;
                        unsigned dv = dvm; asm volatile("" : "+v"(dv));
#pragma unroll
                        for (int hf = 0; hf < 2; ++hf)
#pragma unroll
                            for (int r = 0; r < 16; ++r) { const float bv = *(const LAS float*)(bb + 4 * (32 * hf + 16 * (r >> 3) + (r & 7)));
                                const int M = ((int)(dv << (31 - (hf * 16 + r)))) >> 31;
                                sA[hf][r] = __int_as_float((__float_as_int(sA[hf][r] + bv) & M) | (NEGB & ~M)); }
                    }
                }
                softmax_step(sA[0], sA[1], m1, l1, ng1, O1, j == 0, p1);
            }
            const LAS unsigned char* vp = Vb + q * KROW + hi * 16;
#pragma unroll
            for (int dt = 0; dt < 2; ++dt)
#pragma unroll
                for (int c = 0; c < 4; ++c) {
                    const h8 vf = *(const LAS h8*)(vp + dt * 32 * KROW + c * 32);
                    O1[dt] = __builtin_amdgcn_mfma_f32_32x32x16_f16(vf, p1[c], O1[dt], 0, 0, 0);
                }
            if (MODE == 1) {
                __builtin_amdgcn_sched_barrier(0);
                f32x16 sB[2]; h8 p2[4];
#pragma unroll
                for (int hf = 0; hf < 2; ++hf) {
#pragma unroll
                    for (int c = 2; c < 4; ++c) {
                        const h8 kf = *(const LAS h8*)(kp + hf * 32 * KROW + c * 32);
                        if (c == 2) sB[hf] = __builtin_amdgcn_mfma_f32_32x32x16_f16(kf, qf[c], ng2, 0, 0, 0);
                        else sB[hf] = __builtin_amdgcn_mfma_f32_32x32x16_f16(kf, qf[c], sB[hf], 0, 0, 0);
                    }
                }
                softmax_step(sB[0], sB[1], m2, l2, ng2, O2, j == 0, p2);
#pragma unroll
                for (int dt = 0; dt < 2; ++dt)
#pragma unroll
                    for (int c = 0; c < 4; ++c) {
                        const h8 vf = *(const LAS h8*)(vp + dt * 32 * KROW + c * 32);
                        O2[dt] = __builtin_amdgcn_mfma_f32_32x32x16_f16(vf, p2[c], O2[dt], 0, 0, 0);
                    }
            }
        }
        if (j + 1 < nt) ATT_STORE((j + 1) & 1);
        __syncthreads();
    }
#undef ATT_LOAD
#undef ATT_STORE
    h16* yrow = Y + (size_t)(qrow0 + q) * DM + ycol;
    if (MODE != 1) {
        float lt = xsum32(l1);
        if (MODE == 0) lt += ex2(sinkv - m1);
        const float inv = 1.f / lt;
#pragma unroll
        for (int dt = 0; dt < 2; ++dt)
#pragma unroll
            for (int g4 = 0; g4 < 4; ++g4) { u32x2 w; w.x = pkh2(O1[dt][4 * g4] * inv, O1[dt][4 * g4 + 1] * inv); w.y = pkh2(O1[dt][4 * g4 + 2] * inv, O1[dt][4 * g4 + 3] * inv);
                *(u32x2*)(yrow + 32 * dt + 8 * g4 + 4 * hi) = w; }
    } else {
        const float i1 = 1.f / xsum32(l1), i2 = lam / xsum32(l2);
        float ss = 0.f;
#pragma unroll
        for (int dt = 0; dt < 2; ++dt)
#pragma unroll
            for (int r = 0; r < 16; ++r) { const float o = O1[dt][r] * i1 - O2[dt][r] * i2; O1[dt][r] = o; ss += o * o; }
        ss = xsum32(ss);
        const float rr = __builtin_amdgcn_rsqf(ss * (1.f / 64.f) + EPS) * (1.f - lam_init);
#pragma unroll
        for (int dt = 0; dt < 2; ++dt)
#pragma unroll
            for (int g4 = 0; g4 < 4; ++g4) { const int d0 = 32 * dt + 8 * g4 + 4 * hi; const f32x4 sg = *(const f32x4*)(subg + d0);
                u32x2 w; w.x = pkh2(O1[dt][4 * g4] * rr * sg[0], O1[dt][4 * g4 + 1] * rr * sg[1]); w.y = pkh2(O1[dt][4 * g4 + 2] * rr * sg[2], O1[dt][4 * g4 + 3] * rr * sg[3]);
                *(u32x2*)(yrow + d0) = w; }
    }
}

__device__ __forceinline__ void conv_unit(LAS unsigned char* lds, const h16* __restrict__ PRJ, h16* __restrict__ Y, int seqrow0, int seqlen, int t0,
                                          const float* __restrict__ cw, const float* __restrict__ cb, const float* __restrict__ lg, const float* __restrict__ lb) {
    int tid_ = threadIdx.x; asm volatile("" : "+v"(tid_));
    const int tid = tid_, lane = tid & 63, wid = tid >> 6;
    LAS float* hb = (LAS float*)lds;
    LAS float* ob = hb + 62 * 256;
    const int c = tid & 255, th = tid >> 8;
    float w[31];
#pragma unroll
    for (int k = 0; k < 31; ++k) w[k] = cw[k * 256 + c];
    const float bias = cb[c];
    const f32x4 g4 = *(const f32x4*)(lg + 4 * lane), b4 = *(const f32x4*)(lb + 4 * lane);
    {
        h8 av[4], gv[4];
#pragma unroll
        for (int i = 0; i < 4; ++i) {
            const int task = tid + 512 * i, r = task >> 5, c8 = (task & 31) * 8, t = t0 - 15 + r;
            av[i] = h8{}; gv[i] = h8{};
            if (task < 62 * 32 && t >= 0 && t < seqlen) { const h16* rp = PRJ + (size_t)(seqrow0 + t) * INW + 512 + c8; av[i] = *(const h8*)rp; gv[i] = *(const h8*)(rp + 256); }
        }
#pragma unroll
        for (int i = 0; i < 4; ++i) {
            const int task = tid + 512 * i, r = task >> 5, c8 = (task & 31) * 8;
            if (task < 62 * 32) {
                f32x4 o0, o1;
#pragma unroll
                for (int e = 0; e < 4; ++e) { o0[e] = (float)av[i][e] * __builtin_amdgcn_rcpf(1.f + ex2(-(float)gv[i][e] * LOG2E)); o1[e] = (float)av[i][4 + e] * __builtin_amdgcn_rcpf(1.f + ex2(-(float)gv[i][4 + e] * LOG2E)); }
                *(LAS f32x4*)(hb + r * 256 + c8) = o0; *(LAS f32x4*)(hb + r * 256 + c8 + 4) = o1;
            }
        }
    }
    __syncthreads();
    {
        float acc[16];
#pragma unroll
        for (int o = 0; o < 16; ++o) acc[o] = bias;
#pragma unroll
        for (int ir = 0; ir < 46; ++ir) {
            const float v = hb[(16 * th + ir) * 256 + c];
#pragma unroll
            for (int o = 0; o < 16; ++o) { const int k = ir - o; if (k >= 0 && k < 31) acc[o] += v * w[k]; }
        }
#pragma unroll
        for (int o = 0; o < 16; ++o) ob[(16 * th + o) * 256 + c] = acc[o];
    }
    __syncthreads();
#pragma unroll
    for (int tt = 0; tt < 4; ++tt) {
        const int tok = 4 * wid + tt;
        const f32x4 v = *(const LAS f32x4*)(ob + tok * 256 + 4 * lane);
        const float mean = wave_sum((v[0] + v[1]) + (v[2] + v[3])) * (1.f / 256.f);
        const f32x4 d = v - mean;
        const float var = wave_sum((d[0] * d[0] + d[1] * d[1]) + (d[2] * d[2] + d[3] * d[3])) * (1.f / 256.f);
        const float rstd = __builtin_amdgcn_rsqf(var + EPS);
        const f32x4 o = d * rstd * g4 + b4;
        u32x2 wv; wv.x = pkh2(silu_f(o[0]), silu_f(o[1])); wv.y = pkh2(silu_f(o[2]), silu_f(o[3]));
        *(u32x2*)(Y + (size_t)(seqrow0 + t0 + tok) * DM + 256 + 4 * lane) = wv;
    }
    __syncthreads();
}

constexpr size_t WS_BAR = 768 * 1024;
#define XB_TMO      128
#define XB_XCNT(j)  (256  + 64 * (j))
#define XB_XSUB(j)  (1280 + 64 * (j))
#define XB_XGEN(j)  (2304 + 64 * (j))
#define XB_TOP      3328
#define XB_TOPGEN   3392
#define XCD_BAR_WORDS 3456
#define XB_SPIN_CAP (1u << 18)

__device__ __forceinline__ unsigned xb_ld(unsigned* p)              { return __hip_atomic_load(p, __ATOMIC_RELAXED, __HIP_MEMORY_SCOPE_AGENT); }
__device__ __forceinline__ unsigned xb_add(unsigned* p, unsigned v) { return __hip_atomic_fetch_add(p, v, __ATOMIC_RELAXED, __HIP_MEMORY_SCOPE_AGENT); }
__device__ __forceinline__ unsigned xb_xcc_id() { return (unsigned)__builtin_amdgcn_s_getreg((3 << 11) | 20) & 0xFu; }
#define XB_SPIN(cond, bar) do { unsigned _sp = 0; while (cond) { __builtin_amdgcn_s_sleep(1); \
    if ((++_sp & 255u) == 0u) { if (xb_ld(&(bar)[XB_TMO])) break; if (_sp > XB_SPIN_CAP) { atomicAdd(&(bar)[XB_TMO], 1u); break; } } } } while (0)

struct XcdBarrier {
    unsigned* bar; unsigned x;
    volatile LAS unsigned* st;
};

__device__ __forceinline__ XcdBarrier xcd_barrier_post(unsigned* bar, volatile LAS unsigned* st) {
    XcdBarrier b; b.bar = bar; b.x = xb_xcc_id(); b.st = st;
    if (threadIdx.x == 0) (void)xb_add(&bar[XB_XCNT(b.x)], 1u);
    return b;
}
__device__ __forceinline__ void xcd_barrier_complete(unsigned* bar, unsigned x, unsigned& nloc, unsigned& nx) {
    const unsigned G = gridDim.x * gridDim.y * gridDim.z;
    unsigned sum, cnt, mine, sp = 0u;
    for (;;) {
        sum = 0u; cnt = 0u; mine = 0u;
#pragma unroll
        for (unsigned j = 0; j < 16; ++j) { const unsigned c = xb_ld(&bar[XB_XCNT(j)]); sum += c; cnt += (c > 0u) ? 1u : 0u; mine = (j == x) ? c : mine; }
        if (sum == G) break;
        __builtin_amdgcn_s_sleep(1);
        if ((++sp & 255u) == 0u) { if (xb_ld(&bar[XB_TMO])) break; if (sp > XB_SPIN_CAP) { atomicAdd(&bar[XB_TMO], 1u); break; } }
    }
    nloc = mine > 0u ? mine : 1u; nx = cnt > 0u ? cnt : 1u;
}

__device__ __forceinline__ void xcd_barrier(const XcdBarrier& b) {
    asm volatile("s_waitcnt vmcnt(0)" ::: "memory");
    __syncthreads();
    if (threadIdx.x == 0) {
        unsigned* bar = b.bar;
        __builtin_amdgcn_s_waitcnt(0);
        unsigned nloc = b.st[0], nx = b.st[1];
        if (nloc == 0u) { xcd_barrier_complete(bar, b.x, nloc, nx); b.st[0] = nloc; b.st[1] = nx; }
        const unsigned old = xb_add(&bar[XB_XSUB(b.x)], 1u);
        const unsigned gen = old / nloc;
        if (old + 1u == (gen + 1u) * nloc) {
            __builtin_amdgcn_fence(__ATOMIC_RELEASE, "agent");
            asm volatile("s_waitcnt vmcnt(0)" ::: "memory");
            const unsigned og = xb_add(&bar[XB_TOP], 1u);
            const unsigned tg = og / nx;
            if (og + 1u == (tg + 1u) * nx) xb_add(&bar[XB_TOPGEN], 1u);
            else XB_SPIN(xb_ld(&bar[XB_TOPGEN]) == tg, bar);
            __builtin_amdgcn_fence(__ATOMIC_ACQUIRE, "agent");
            xb_add(&bar[XB_XGEN(b.x)], 1u);
            asm volatile("s_waitcnt vmcnt(0)" ::: "memory");
        } else {
            XB_SPIN(xb_ld(&bar[XB_XGEN(b.x)]) == gen, bar);
            __builtin_amdgcn_fence(__ATOMIC_ACQUIRE, "agent");
            asm volatile("s_waitcnt vmcnt(0)" ::: "memory");
        }
    }
    __syncthreads();
}

__device__ __forceinline__ void weight_item(int r, const float* __restrict__ wi, const float* __restrict__ wo, const float* __restrict__ wg, const float* __restrict__ wu, const float* __restrict__ wd,
                                            unsigned char* wb, LAS float* scr, int lane) {
    constexpr int I_IN = 16 * 80, I_OUT = 16 * 32, I_G = 16 * 88;
    if (r < I_IN) { p0_transpose_item(wi, DM, INW, (h16*)wb, 1, scr, r, lane); return; } r -= I_IN;
    if (r < I_OUT) { p0_transpose_item(wo, DM, DM, (h16*)(wb + WO_OFF), 0, scr, r, lane); return; } r -= I_OUT;
    if (r < I_G) { p0_transpose_item(wg, DM, FF, (h16*)(wb + WGU_OFF), 2, scr, r, lane); return; } r -= I_G;
    if (r < I_G) { p0_transpose_item(wu, DM, FF, (h16*)(wb + WGU_OFF), 3, scr, r, lane); return; } r -= I_G;
    p0_transpose_item(wd, FF, DM, (h16*)(wb + WD_OFF), 0, scr, r, lane);
}
constexpr int W_ITEMS = 16 * 80 + 16 * 32 + 2 * 16 * 88 + 44 * 32;

struct Args { const float* in[25]; float* out; unsigned char* ws; int ph_lo, ph_hi; };
constexpr int N_PHASES = 15;
constexpr int N_PHASES_OLD_ = 13;

__global__ void __launch_bounds__(512, 2) mega_fwd(Args a) {
    extern __shared__ __attribute__((aligned(16))) unsigned char lds_raw[];
    LAS unsigned char* lds = (LAS unsigned char*)lds_raw;
    cg::grid_group grid = cg::this_grid();
    int tid = threadIdx.x, lane = tid & 63; const int wave = __builtin_amdgcn_readfirstlane(tid >> 6);
    const int G = gridDim.x, blk = blockIdx.x;
    const int gw = blk * 8 + wave, NGW = G * 8;
    unsigned char* ws = a.ws;
    int zq = 0;
#define ZQ() asm volatile("" : "+s"(zq), "+v"(tid), "+v"(lane))
#define x_in (a.in[0 + zq])
#define c_in (a.in[1 + zq])
#define ctx_in (a.in[2 + zq])
#define cctx_in (a.in[3 + zq])
#define norm1_g (a.in[4 + zq])
#define norm2_g (a.in[5 + zq])
#define w_ada (a.in[6 + zq])
#define b_ada (a.in[7 + zq])
#define w_in (a.in[8 + zq])
#define w_out (a.in[9 + zq])
#define attn_sink (a.in[10 + zq])
#define conv_w (a.in[11 + zq])
#define conv_b (a.in[12 + zq])
#define conv_ln_g (a.in[13 + zq])
#define conv_ln_b (a.in[14 + zq])
#define lq1 (a.in[15 + zq])
#define lk1 (a.in[16 + zq])
#define lq2 (a.in[17 + zq])
#define lk2 (a.in[18 + zq])
#define subln_g (a.in[19 + zq])
#define na_rpb (a.in[20 + zq])
#define w_gate (a.in[21 + zq])
#define w_up (a.in[22 + zq])
#define w_down (a.in[23 + zq])
#define final_g (a.in[24 + zq])
    float* XO = a.out;
    float* MOD = (float*)(ws + WS_MOD);
    float2* ropeA = (float2*)(ws + WS_ROPEA); float2* ropeC = (float2*)(ws + WS_ROPEC);
    h16* XN = (h16*)(ws + WS_XN); float* CR = (float*)(ws + WS_CR); h16* PRJ = (h16*)(ws + WS_PRJ); h16* Y = (h16*)(ws + WS_Y); h16* H = (h16*)(ws + WS_H);
    const int lo = a.ph_lo, hi = a.ph_hi;
#ifndef MK_MASK
#define MK_MASK 0x1ff
#endif
#define IN(k) (lo <= (k) && (k) < hi)
#define INL(x) (((MK_MASK >> (x)) & 1) && IN(pb + (x)))
    volatile LAS unsigned* bst = (volatile LAS unsigned*)(lds + LDS_BYTES - 64);
    if (tid == 0) { bst[0] = 0u; bst[1] = 0u; }
    __syncthreads();
    if (a.ph_lo < 0) grid.sync();
    XcdBarrier xbar = xcd_barrier_post((unsigned*)(ws + WS_BAR), bst);
#define SEAM(k) do { if (IN(k) && IN((k) + 1)) { for (int rs_ = 0; rs_ < MK_REP_SYNC; ++rs_) xcd_barrier(xbar); } } while (0)

    if (((MK_MASK >> 7) & 1) && IN(0)) {
        ZQ();
        for (int rep_ = 0; rep_ < MK_REP_ADA; ++rep_) for (int t = gw; t < 96 * 8; t += NGW) p0_ada_task(c_in, cctx_in, w_ada, b_ada, MOD, t, lane, rep_ == 0 ? 1.f : 0.f);
        LAS float* scr = (LAS float*)(lds + wave * 16384);
        for (int rep_ = 0; rep_ < MK_REP_TR; ++rep_) for (int it = gw; it < W_ITEMS; it += NGW)
            weight_item(it, w_in, w_out, w_gate, w_up, w_down, ws + WS_W, scr, lane);
        for (int i = blk * 512 + tid; i < SEQ * 48; i += G * 512) {
            if (i < SEQ * 32) { const int t = i >> 5, f = i & 31; const float pos = (f < 16) ? (float)(t >> 6) : (float)(t & 63);
                const float inv = exp2f(-(float)(f & 15) * (13.287712379549449f / 16.f)); const float ang = pos * inv; ropeA[i] = make_float2(__cosf(ang), __sinf(ang)); }
            else { const int i2 = i - SEQ * 32; const int t = i2 >> 4, f = i2 & 15; const float pos = (f < 8) ? (float)(t >> 6) : (float)(t & 63);
                const float inv = exp2f(-(float)(f & 7) * (13.287712379549449f / 8.f)); const float ang = pos * inv; ropeC[i2] = make_float2(__cosf(ang), __sinf(ang)); }
        }
    }
    SEAM(0);
    float* SSQ = (float*)(ws + WS_SSQ);
    for (int rep_ = 0; rep_ < MK_REP_N1; ++rep_) if (((MK_MASK >> 7) & 1) && IN(1)) {
        ZQ();
        prep_rows(gw, NGW, lane, x_in, ctx_in, XN, norm1_g, MOD, 1 * DM, SSQ, MT);
        for (int t = blk; t < (SHWW / 64); t += G) {
            const int l = t >> 7, p0 = (t & 127) * 64;
            unsigned char* wb = ws + WS_W + (size_t)l * WS_WSTRIDE;
            const h16* wrow = (p0 < INW) ? (const h16*)wb + (size_t)p0 * DM : (const h16*)(wb + WGU_OFF) + (size_t)(p0 - INW) * DM;
            shw_block_task(lds, wrow, MOD + (size_t)l * 9 * MODW, (p0 < INW) ? 0 : 3 * DM, (float*)(wb + SHW_OFF) + p0);
        }
    }
    SEAM(1);

    for (int l = 0; l < 2; ++l) {
        const int pb = 2 + 6 * l;
        const bool ctx_needed = (l == 0);
        const float* modl = MOD + (size_t)l * 9 * MODW;
        unsigned char* wb = ws + WS_W + (size_t)l * WS_WSTRIDE;
#define srcX0 ((l == 0) ? x_in : (const float*)XO)
#define srcC0 ((l == 0) ? ctx_in : (const float*)CR)
        const int Mff = ctx_needed ? MT : MX;
        for (int rep_ = 0; rep_ < MK_REP_IN; ++rep_) if (INL(0)) {
            ZQ();
            pg8::Gemm g{(const pg8::bf16_t*)XN, (const pg8::bf16_t*)wb, MT, INW, DM};
            PrefOrder S; S.init(MT, INW, G, blk); S.ssq = SSQ + (size_t)(2 * l) * MT; S.shw = (const float*)(wb + SHW_OFF); S.ldsb = lds; S.na = 0;
            EpiInProj E{PRJ, ropeA, ropeC, lds, 0};
            pg8::gemm_phase<EpiInProj, PrefOrder, true, true>(lds, g, S, E);
        }
        SEAM(pb + 0);
        for (int rep_ = 0; rep_ < MK_REP_MIX; ++rep_) if (INL(1)) {
            ZQ();
            const float lam_init = 0.8f - 0.6f * expf(-0.3f * (float)l);
            float d1 = 0.f, d2 = 0.f;
            for (int i = 0; i < 32; ++i) { d1 += lq1[l * 32 + i] * lk1[l * 32 + i]; d2 += lq2[l * 32 + i] * lk2[l * 32 + i]; }
            const float lam = expf(d1) - expf(d2) + lam_init;
            const float* sinkp = attn_sink + l * 4; const float* rpb = na_rpb + l * 4 * 465; const float* subg = subln_g + l * 64;
#ifndef MK_CTX
#define MK_CTX 15
#endif
#ifndef MK_MIX
#define MK_MIX 0x1f
#endif
            const int nau = ctx_needed ? 288 : 256, ncu = ctx_needed ? 576 : 512;
            if (MK_MIX & 1) for (int w = blk; w < nau; w += G) { const bool cq = w >= 256; const int u = w & 255;
                attn_unit<1>(lds, PRJ, Y, cq ? (u >> 2) : (u >> 5), cq ? (u & 3) : ((u >> 3) & 3), cq ? 0 : (u & 7), cq, sinkp, rpb, lam, lam_init, subg); }
            asm volatile("" ::: "memory");
            if (MK_MIX & 2) for (int w = (blk + 32) % G; w < nau; w += G) { const bool cq = w >= 256; const int u = w & 255;
                attn_unit<0>(lds, PRJ, Y, cq ? (u >> 2) : (u >> 5), cq ? (u & 3) : ((u >> 4) & 1), cq ? 0 : (u & 15), cq, sinkp, rpb, lam, lam_init, subg); }
            asm volatile("" ::: "memory");
            if (MK_MIX & 4) for (int w = (blk + 64) % G; w < nau; w += G) { const bool cq = w >= 256; const int u = w & 255;
                attn_unit<2>(lds, PRJ, Y, cq ? (u >> 2) : (u >> 5), cq ? (u & 3) : ((u >> 3) & 3), cq ? 0 : (u & 7), cq, sinkp, rpb, lam, lam_init, subg); }
            asm volatile("" ::: "memory");
            if (MK_MIX & 8) for (int w = (blk + 96) % G; w < ncu; w += G) { const bool cq = w >= 512; const int v = w - 512;
                conv_unit(lds, PRJ, Y, cq ? MX + (v >> 3) * CTXL : (w >> 6) * SEQ, cq ? CTXL : SEQ, cq ? (v & 7) * 32 : (w & 63) * 32, conv_w + l * 31 * 256, conv_b + l * 256, conv_ln_g + l * 256, conv_ln_b + l * 256); }
        }
        SEAM(pb + 1);
        for (int rep_ = 0; rep_ < MK_REP_OUT; ++rep_) if (INL(2)) {
            ZQ();
            pg8::Gemm g{(const pg8::bf16_t*)Y, (const pg8::bf16_t*)(wb + WO_OFF), Mff, DM, DM}; pg8::StaticOrder S; S.init(Mff, DM, G, blk);
            EpiResid E{srcX0, srcC0, XO, CR, modl + 2 * DM, XN, norm2_g + l * DM, modl + 4 * DM, SSQ + (size_t)(2 * l + 1) * MT, (rep_ == MK_REP_OUT - 1) ? 1 : 0, (rep_ == MK_REP_OUT - 1) ? 1.f : 0.f};
            pg8::gemm_phase<EpiResid, pg8::StaticOrder, true, true>(lds, g, S, E);
            if (l == 0 && rep_ == MK_REP_OUT - 1) {
                const int nwg = (Mff / 256) * (DM / 256), rounds = (nwg + G - 1) / G, rem = nwg - (rounds - 1) * G;
                const int first = (rem < G) ? rem : 0, nidle = G - first;
                if (blk >= first) {
                    LAS float* scr = (LAS float*)(lds + wave * 16384);
                    for (int it = (blk - first) * 8 + wave; it < W_ITEMS; it += nidle * 8)
                        weight_item(it, w_in + (size_t)DM * INW, w_out + (size_t)DM * DM, w_gate + (size_t)DM * FF, w_up + (size_t)DM * FF, w_down + (size_t)FF * DM, ws + WS_W + WS_WSTRIDE, scr, lane);
                    for (int t = 96 * 8 + (blk - first) * 8 + wave; t < 2 * 96 * 8; t += nidle * 8) p0_ada_task(c_in, cctx_in, w_ada, b_ada, MOD, t, lane, 1.f);
                }
            }
        }
        SEAM(pb + 2);
        for (int rep_ = 0; rep_ < MK_REP_GU; ++rep_) if (INL(3)) {
            ZQ();
            pg8::Gemm g{(const pg8::bf16_t*)XN, (const pg8::bf16_t*)(wb + WGU_OFF), Mff, 2 * FF, DM};
            PrefOrder S; S.init(Mff, 2 * FF, G, blk); S.ssq = SSQ + (size_t)(2 * l + 1) * MT; S.shw = (const float*)(wb + SHW_OFF) + INW; S.ldsb = lds; S.na = 0;
#ifdef MK_GU_VARIANT
            if (rep_ == 0) { EpiSwigluT<true> E{H, lds, 0}; pg8::gemm_phase<EpiSwigluT<true>, PrefOrder, true, true>(lds, g, S, E); }
            else
#endif
            { EpiSwigluT<false> E{H, lds, 0}; pg8::gemm_phase<EpiSwigluT<false>, PrefOrder, true, true>(lds, g, S, E); }
        }
        SEAM(pb + 3);
        for (int rep_ = 0; rep_ < MK_REP_DN; ++rep_) if (INL(4)) {
            ZQ();
            {
                pg8::Gemm g{(const pg8::bf16_t*)H, (const pg8::bf16_t*)(wb + WD_OFF), MX, DM, FF}; pg8::StaticOrder S; S.init(MX, DM, G, blk);
                EpiResid E{XO, CR, XO, CR, modl + 5 * DM, XN, norm1_g + (l + 1 < 2 ? l + 1 : 1) * DM, MOD + (size_t)(l + 1 < 2 ? l + 1 : 1) * 9 * MODW + 1 * DM, SSQ + (size_t)(2 * (l + 1 < 2 ? l + 1 : 1)) * MT, (l == 0 && rep_ == MK_REP_DN - 1) ? 1 : 0, (rep_ == MK_REP_DN - 1) ? 1.f : 0.f};
                pg8::gemm_phase<EpiResid, pg8::StaticOrder, true, true>(lds, g, S, E);
            }
            if (ctx_needed) {
                pg8::Gemm g{(const pg8::bf16_t*)H, (const pg8::bf16_t*)(wb + WD_OFF), MT, DM, FF}; CtxSplitOrder S{G, blk};
                EpiPartial E{(h16*)(ws + WS_PART)};
                pg8::gemm_phase<EpiPartial, CtxSplitOrder, true, true>(lds, g, S, E);
            }
        }
        SEAM(pb + 4);
        if (ctx_needed) {
            if (INL(4) && IN(pb + 5)) { ZQ(); ctx_fix_rows(gw, NGW, lane, CR, (const h16*)(ws + WS_PART), modl + 5 * DM + 8 * MODW, XN, norm1_g + DM, MOD + (size_t)9 * MODW + 1 * DM + 8 * MODW, SSQ + (size_t)2 * MT);
                for (int t = blk; t < (SHWW / 64); t += G) {
                    const int p0 = t * 64;
                    unsigned char* wb1 = ws + WS_W + WS_WSTRIDE;
                    const h16* wrow = (p0 < INW) ? (const h16*)wb1 + (size_t)p0 * DM : (const h16*)(wb1 + WGU_OFF) + (size_t)(p0 - INW) * DM;
                    shw_block_task(lds, wrow, MOD + (size_t)9 * MODW, (p0 < INW) ? 0 : 3 * DM, (float*)(wb1 + SHW_OFF) + p0);
                } }
            SEAM(pb + 5);
        }
    }
    if (((MK_MASK >> 8) & 1) && IN(14)) { ZQ(); final_norm_rows(gw, NGW, lane, XO, final_g); }
#undef IN
#undef SEAM
#undef srcX0
#undef srcC0
#undef x_in
#undef c_in
#undef ctx_in
#undef cctx_in
#undef norm1_g
#undef norm2_g
#undef w_ada
#undef b_ada
#undef w_in
#undef w_out
#undef attn_sink
#undef conv_w
#undef conv_b
#undef conv_ln_g
#undef conv_ln_b
#undef lq1
#undef lk1
#undef lq2
#undef lk2
#undef subln_g
#undef na_rpb
#undef w_gate
#undef w_up
#undef w_down
#undef final_g
}

#ifndef MK_PER_PHASE
#define MK_PER_PHASE 0
#endif
extern "C" void kernel_launch(void* const* d_in, const int* in_sizes, int n_in, void* d_out, int out_size, void* d_ws, size_t ws_size, hipStream_t stream) {
    static int grid = 0;
    if (grid == 0) {
        int dev = 0, cus = 0, per_cu = 0;
        (void)hipGetDevice(&dev);
        (void)hipDeviceGetAttribute(&cus, hipDeviceAttributeMultiprocessorCount, dev);
        if (hipFuncSetAttribute((const void*)mega_fwd, hipFuncAttributeMaxDynamicSharedMemorySize, LDS_BYTES) != hipSuccess) fprintf(stderr, "kernel_launch: hipFuncSetAttribute failed\n");
        if (hipOccupancyMaxActiveBlocksPerMultiprocessor(&per_cu, (const void*)mega_fwd, 512, LDS_BYTES) != hipSuccess || per_cu < 1) { fprintf(stderr, "kernel_launch: occupancy query gave %d\n", per_cu); per_cu = 1; }
        (void)hipGetLastError();
        grid = cus * per_cu;
        if (n_in != 25 || ws_size < WS_END) fprintf(stderr, "kernel_launch: unexpected n_in %d / ws %zu\n", n_in, ws_size);
    }
    (void)hipMemsetAsync((char*)d_ws, 0, 1u << 20, stream);
    Args a{};
    for (int i = 0; i < 25; ++i) a.in[i] = (const float*)d_in[i];
    a.out = (float*)d_out; a.ws = (unsigned char*)d_ws;
#if MK_PER_PHASE
    for (int p = 0; p < N_PHASES; ++p) {
        a.ph_lo = p; a.ph_hi = p + 1;
        void* args[] = {&a};
        hipError_t e = hipLaunchCooperativeKernel((const void*)mega_fwd, dim3(grid), dim3(512), args, LDS_BYTES, stream);
        if (e != hipSuccess) { fprintf(stderr, "kernel_launch: launch of phase %d failed: %s (grid %d)\n", p, hipGetErrorString(e), grid); break; }
    }
#else
    a.ph_lo = 0; a.ph_hi = N_PHASES;
    void* args[] = {&a};
    hipError_t e = hipLaunchCooperativeKernel((const void*)mega_fwd, dim3(grid), dim3(512), args, LDS_BYTES, stream);
    if (e != hipSuccess) fprintf(stderr, "kernel_launch: cooperative launch failed: %s (grid %d)\n", hipGetErrorString(e), grid);
#endif
}
```
